# Optimizing an MI355X kernel written in HIP

```python
import math
import jax, jax.numpy as jnp
from jax import lax
import numpy as np

D_MODEL = 1024
BATCH = 16
SEQ = 4096
DEPTH = 1
DEC_BATCH = 8
DEC_SEQ = 8192
PAST_LEN = 128

HEAD_DIM = 64
N_HEADS_A = 8
N_HEADS_B = 8
WIDTH_A = N_HEADS_A * HEAD_DIM
WIDTH_B = N_HEADS_B * HEAD_DIM
MIX_WIDTH = WIDTH_A + WIDTH_B
DILATED_PATTERNS = ((128, 1), (512, 4), (2048, 16))
GRID_W = 64
NA_ROWS_MAX = 8
NA_COLS = 16
N_MEM = 256
N_HEADS_X = 4
HEAD_DIM_X = D_MODEL // N_HEADS_X
D_FF = 4 * D_MODEL
ROPE_THETA = 10000.0
LN_EPS = 1e-5
ALPHA = (2 * DEPTH) ** 0.25
BETA = (8 * DEPTH) ** -0.25
NEG_INF = -1e30

kernel_name = 'hybrid_dilated_neighbourhood_encoder'


def layer_norm(x, g, b):
    xf = x.astype(jnp.float32)
    mu = jnp.mean(xf, axis=-1, keepdims=True)
    var = jnp.mean(jnp.square(xf - mu), axis=-1, keepdims=True)
    y = (xf - mu) * lax.rsqrt(var + LN_EPS)
    return (y * g.astype(jnp.float32) + b.astype(jnp.float32)).astype(x.dtype)


def rms_norm(x, g):
    xf = x.astype(jnp.float32)
    y = xf * lax.rsqrt(jnp.mean(jnp.square(xf), axis=-1, keepdims=True) + LN_EPS)
    return y * g.astype(jnp.float32)


def rotary(x):
    T = x.shape[1]
    half = HEAD_DIM // 2
    inv = ROPE_THETA ** (-jnp.arange(half, dtype=jnp.float32) / half)
    ang = jnp.arange(T, dtype=jnp.float32)[:, None] * inv[None, :]
    cos = jnp.cos(ang)[None, :, None, :]
    sin = jnp.sin(ang)[None, :, None, :]
    x1, x2 = x[..., :half], x[..., half:]
    return jnp.concatenate([x1 * cos - x2 * sin, x2 * cos + x1 * sin], axis=-1)


def dilated_window_attention(q, k, v, window, dilation):
    B, T, H, hd = q.shape
    n_side = (window // 2) // dilation
    L = T // dilation
    nb = -(-L // n_side)
    Lp = nb * n_side

    def to_sub(a):
        return a.reshape(B, L, dilation, H, hd).transpose(0, 2, 1, 3, 4)

    qs, ks, vs = to_sub(q), to_sub(k), to_sub(v)
    qs = jnp.pad(qs, ((0, 0), (0, 0), (0, Lp - L), (0, 0), (0, 0)))
    kpad = ((0, 0), (0, 0), (n_side, Lp - L + n_side), (0, 0), (0, 0))
    ks = jnp.pad(ks, kpad)
    vs = jnp.pad(vs, kpad)
    qb = qs.reshape(B, dilation, nb, n_side, H, hd)
    kidx = n_side * jnp.arange(nb)[:, None] + jnp.arange(3 * n_side)[None, :]
    kb = ks[:, :, kidx]
    vb = vs[:, :, kidx]
    qi = n_side * jnp.arange(nb)[:, None] + jnp.arange(n_side)[None, :]
    kj = kidx - n_side
    valid = ((kj[:, None, :] >= 0) & (kj[:, None, :] < L)
             & (jnp.abs(kj[:, None, :] - qi[:, :, None]) <= n_side))
    s = jnp.einsum('bdnqhc,bdnkhc->bdnhqk', qb, kb) * (hd ** -0.5)
    s = jnp.where(valid[None, None, :, None], s, NEG_INF)
    m = jnp.max(s, axis=-1, keepdims=True)
    p = jnp.exp(s - m)
    den = jnp.sum(p, axis=-1)
    o = jnp.einsum('bdnhqk,bdnkhc->bdnqhc', p, vb) / den.transpose(0, 1, 2, 4, 3)[..., None]
    lse = m[..., 0] + jnp.log(den)
    o = o.reshape(B, dilation, Lp, H, hd)[:, :, :L].transpose(0, 2, 1, 3, 4).reshape(B, T, H, hd)
    lse = lse.transpose(0, 1, 2, 4, 3).reshape(B, dilation, Lp, H)[:, :, :L]
    lse = lse.transpose(0, 2, 1, 3).reshape(B, T, H)
    return o, lse


def dilated_mixture_attention(q, k, v):
    outs, lses = [], []
    for window, dilation in DILATED_PATTERNS:
        o, lse = dilated_window_attention(q, k, v, window, dilation)
        outs.append(o)
        lses.append(lse)
    wts = jax.nn.softmax(jnp.stack(lses, axis=0), axis=0)
    return jnp.einsum('pbth,pbthc->bthc', wts, jnp.stack(outs, axis=0))


def neighbourhood_attention(q, k, v, rpb):
    B, T, H, hd = q.shape
    rows = T // GRID_W
    kh = min(NA_ROWS_MAX, rows)
    r = jnp.arange(rows)
    rs = jnp.clip(r - kh // 2, 0, rows - kh)
    row_idx = rs[:, None] + jnp.arange(kh)[None, :]
    c = jnp.arange(GRID_W)
    cs = jnp.clip(c - NA_COLS // 2, 0, GRID_W - NA_COLS)
    qg = q.reshape(B, rows, GRID_W, H, hd)
    kg = k.reshape(B, rows, GRID_W, H, hd)[:, row_idx]
    vg = v.reshape(B, rows, GRID_W, H, hd)[:, row_idx]
    s = jnp.einsum('brqhc,brawhc->brhqaw', qg, kg) * (hd ** -0.5)
    dr = row_idx - r[:, None]
    dc = c[None, :] - c[:, None]
    ridx = (dr + NA_ROWS_MAX - 1)[:, :, None, None]
    cidx = (jnp.clip(dc, -(NA_COLS - 1), NA_COLS - 1) + NA_COLS - 1)[None, None]
    bias = rpb.astype(jnp.float32)[:, ridx, cidx]
    s = s + bias.transpose(1, 0, 3, 2, 4)[None]
    col_ok = (c[None, :] >= cs[:, None]) & (c[None, :] < cs[:, None] + NA_COLS)
    s = jnp.where(col_ok[:, None, :], s, NEG_INF)
    p = jax.nn.softmax(s.reshape(s.shape[:4] + (kh * GRID_W,)), axis=-1).reshape(s.shape)
    o = jnp.einsum('brhqaw,brawhc->brqhc', p, vg)
    return o.reshape(B, T, H, hd)


def token_mixer(x, w_in, rpb, g_mix_a, g_mix_b, w_out):
    B, T, _ = x.shape
    proj = (x @ w_in).astype(jnp.float32)
    splits = [WIDTH_A, 2 * WIDTH_A, 3 * WIDTH_A, 3 * WIDTH_A + WIDTH_B, 3 * WIDTH_A + 2 * WIDTH_B]
    qa, ka, va, qb, kb, vb = jnp.split(proj, splits, axis=-1)
    qa = rotary(qa.reshape(B, T, N_HEADS_A, HEAD_DIM))
    ka = rotary(ka.reshape(B, T, N_HEADS_A, HEAD_DIM))
    va = va.reshape(B, T, N_HEADS_A, HEAD_DIM)
    oa = dilated_mixture_attention(qa, ka, va).reshape(B, T, WIDTH_A)
    ob = neighbourhood_attention(qb.reshape(B, T, N_HEADS_B, HEAD_DIM),
                                 kb.reshape(B, T, N_HEADS_B, HEAD_DIM),
                                 vb.reshape(B, T, N_HEADS_B, HEAD_DIM), rpb).reshape(B, T, WIDTH_B)
    y = jnp.concatenate([rms_norm(oa, g_mix_a), rms_norm(ob, g_mix_b)], axis=-1).astype(x.dtype)
    return y @ w_out


def memory_cross_attention(x, mem, w_xq, w_xkv, w_xo):
    B, T, D = x.shape
    M = mem.shape[1]
    q = (x @ w_xq).astype(jnp.float32).reshape(B, T, N_HEADS_X, HEAD_DIM_X)
    kv = (mem @ w_xkv).astype(jnp.float32).reshape(B, M, 2, N_HEADS_X, HEAD_DIM_X)
    k, v = kv[:, :, 0], kv[:, :, 1]
    s = jnp.einsum('bthc,bmhc->bhtm', q, k) * (HEAD_DIM_X ** -0.5)
    p = jax.nn.softmax(s, axis=-1)
    o = jnp.einsum('bhtm,bmhc->bthc', p, v).reshape(B, T, D).astype(x.dtype)
    return o @ w_xo


def squared_relu_mlp(x, w_up, w_down):
    return jnp.square(jax.nn.relu(x @ w_up)) @ w_down


def encoder_trunk(x, mem, ln_in_g, ln_in_b, w_in, rpb, g_mix_a, g_mix_b, w_out, ln1_g, ln1_b,
                  w_xq, w_xkv, w_xo, ln2_g, ln2_b, w_up, w_down, ln3_g, ln3_b):
    x = layer_norm(x, ln_in_g, ln_in_b)
    for l in range(DEPTH):
        x = layer_norm(ALPHA * x + token_mixer(x, w_in[l], rpb[l], g_mix_a[l], g_mix_b[l], w_out[l]),
                       ln1_g[l], ln1_b[l])
        x = layer_norm(ALPHA * x + memory_cross_attention(x, mem, w_xq[l], w_xkv[l], w_xo[l]),
                       ln2_g[l], ln2_b[l])
        x = layer_norm(ALPHA * x + squared_relu_mlp(x, w_up[l], w_down[l]), ln3_g[l], ln3_b[l])
    return x


def setup_inputs(seed: int = 0) -> dict:
    key = jax.random.key(seed)
    ks = jax.random.split(key, 24)
    D = D_MODEL

    def nrm(k, shape, scale):
        return jax.random.normal(k, shape, jnp.float32) * scale

    return {
        'x_prompt': nrm(ks[0], (BATCH, SEQ, D), 1.0),
        'x_sample': nrm(ks[1], (DEC_BATCH, DEC_SEQ, D), 1.0),
        'mem_prompt': nrm(ks[2], (BATCH, N_MEM, D), 1.0),
        'mem_sample': nrm(ks[3], (DEC_BATCH, N_MEM, D), 1.0),
        'ln_in_g': 1.0 + nrm(ks[4], (D,), 0.05),
        'ln_in_b': nrm(ks[5], (D,), 0.02),
        'w_in': nrm(ks[6], (DEPTH, D, 3 * MIX_WIDTH), D ** -0.5),
        'rpb': nrm(ks[7], (DEPTH, N_HEADS_B, 2 * NA_ROWS_MAX - 1, 2 * NA_COLS - 1), 0.5),
        'g_mix_a': 1.0 + nrm(ks[8], (DEPTH, WIDTH_A), 0.05),
        'g_mix_b': 1.0 + nrm(ks[9], (DEPTH, WIDTH_B), 0.05),
        'w_out': nrm(ks[10], (DEPTH, MIX_WIDTH, D), BETA * MIX_WIDTH ** -0.5),
        'ln1_g': 1.0 + nrm(ks[11], (DEPTH, D), 0.05),
        'ln1_b': nrm(ks[12], (DEPTH, D), 0.02),
        'w_xq': nrm(ks[13], (DEPTH, D, D), D ** -0.5),
        'w_xkv': nrm(ks[14], (DEPTH, D, 2 * D), D ** -0.5),
        'w_xo': nrm(ks[15], (DEPTH, D, D), BETA * D ** -0.5),
        'ln2_g': 1.0 + nrm(ks[16], (DEPTH, D), 0.05),
        'ln2_b': nrm(ks[17], (DEPTH, D), 0.02),
        'w_up': nrm(ks[18], (DEPTH, D, D_FF), D ** -0.5),
        'w_down': nrm(ks[19], (DEPTH, D_FF, D), BETA * D_FF ** -0.5),
        'ln3_g': 1.0 + nrm(ks[20], (DEPTH, D), 0.05),
        'ln3_b': nrm(ks[21], (DEPTH, D), 0.02),
    }


def reference(x_prompt, x_sample, mem_prompt, mem_sample, ln_in_g, ln_in_b, w_in, rpb, g_mix_a,
              g_mix_b, w_out, ln1_g, ln1_b, w_xq, w_xkv, w_xo, ln2_g, ln2_b, w_up, w_down,
              ln3_g, ln3_b):
    y_prompt = encoder_trunk(x_prompt, mem_prompt, ln_in_g, ln_in_b, w_in, rpb, g_mix_a, g_mix_b,
                             w_out, ln1_g, ln1_b, w_xq, w_xkv, w_xo, ln2_g, ln2_b, w_up, w_down,
                             ln3_g, ln3_b)
    y_sample = encoder_trunk(x_sample, mem_sample, ln_in_g, ln_in_b, w_in, rpb, g_mix_a, g_mix_b,
                             w_out, ln1_g, ln1_b, w_xq, w_xkv, w_xo, ln2_g, ln2_b, w_up, w_down,
                             ln3_g, ln3_b)
    return (y_prompt, y_sample)
```

```cpp
#include <hip/hip_runtime.h>
#include <hip/hip_cooperative_groups.h>
#include <cstdio>
namespace cg = cooperative_groups;

#define DI __device__ __forceinline__
#define PG8_LAS __attribute__((address_space(3)))
typedef unsigned short bf16_t;
typedef short bf16x8 __attribute__((ext_vector_type(8)));
typedef short s16x4 __attribute__((ext_vector_type(4)));
typedef float f32x4 __attribute__((ext_vector_type(4)));
typedef unsigned u32x4 __attribute__((ext_vector_type(4)));
typedef unsigned u32x2 __attribute__((ext_vector_type(2)));

#ifndef PH_MASK
#define PH_MASK 0xffff
#endif
#ifndef N_LAUNCHES
#define N_LAUNCHES 1
#endif

constexpr int MTOK = 131072, MP = 65536, NMEM = 6144;
constexpr float ALPHA_C = 1.189207115002721f, LN_EPS_C = 1e-5f, LOG2E_C = 1.4426950408889634f;
constexpr size_t MiB = (size_t)1 << 20;
constexpr size_t WS_XN = 0, WS_QKV = 256 * MiB, WS_Z1 = 256 * MiB, WS_QX = 512 * MiB, WS_OC = 768 * MiB, WS_X1 = 0, WS_Z2 = 256 * MiB, WS_X2 = 512 * MiB, WS_H = 0, WS_Z3 = 768 * MiB;
constexpr size_t WS_NEED = 1024 * MiB;
constexpr size_t OUT_O = 0, OUT_SM = 256 * MiB;
constexpr size_t SM_WIN = OUT_SM, SM_WOUT = SM_WIN + 6 * MiB, SM_WXQ = SM_WOUT + 2 * MiB, SM_WXKV = SM_WXQ + 2 * MiB, SM_WXO = SM_WXKV + 4 * MiB, SM_WUP = SM_WXO + 2 * MiB,
                 SM_WDOWN = SM_WUP + 8 * MiB, SM_MEMB = SM_WDOWN + 8 * MiB, SM_KM = SM_MEMB + 12 * MiB, SM_VTM = SM_KM + 12 * MiB, SM_RC = SM_VTM + 12 * MiB, SM_RS = SM_RC + 1 * MiB;

struct Params {
    const float *x_prompt, *x_sample, *mem_prompt, *mem_sample, *ln_in_g, *ln_in_b, *w_in, *rpb, *g_mix_a, *g_mix_b, *w_out, *ln1_g, *ln1_b, *w_xq, *w_xkv, *w_xo, *ln2_g, *ln2_b, *w_up, *w_down, *ln3_g, *ln3_b;
    unsigned char* out; unsigned char* ws; int ph_lo, ph_hi;
};

DI unsigned cvt_pk_bf16(float lo, float hi) { unsigned r; asm("v_cvt_pk_bf16_f32 %0, %1, %2" : "=v"(r) : "v"(lo), "v"(hi)); return r; }
DI float bf_lo(unsigned w) { return __uint_as_float(w << 16); }
DI float bf_hi(unsigned w) { return __uint_as_float(w & 0xffff0000u); }
DI float wave_sum(float v) { for (int o = 32; o >= 1; o >>= 1) v += __shfl_xor(v, o); return v; }

namespace pg8 {
constexpr int BM = 256, BK = 64, HALF = 128, HTB = HALF * BK * 2, STAGE_BYTES = 8 * HTB, NXCD = 8, WGM = 8;
__host__ __device__ __forceinline__ int lds_byte(int r, int c) { const int st = (r >> 4) * 2 + (c >> 5), rr = r & 15, cc = c & 31, ob = rr * 64 + cc * 2; return st * 1024 + (ob ^ (((ob >> 9) & 1) << 5)); }
__host__ __device__ __forceinline__ void stage_rc(int b, int& R, int& C) { const int st = b / 1024, sb = b % 1024, swz = sb ^ (((sb >> 9) & 1) << 5); R = (st >> 1) * 16 + swz / 64; C = (st & 1) * 32 + (swz % 64) / 2; }
__host__ __device__ __forceinline__ int perm32(int rho) { const int n = rho >> 4, i = rho & 15; return 8 * (i >> 2) + 4 * n + (i & 3); }
struct Unit { int pm, pn; };
struct Gemm { const bf16_t* A; const bf16_t* Bt; int M, N, K; };
struct StaticOrder {
    int nM, nN, nwg, G, c;
    __device__ void init(int M, int N, int G_, int c_) { nM = M / BM; nN = N / BM; nwg = nM * nN; G = G_; c = c_; }
    __device__ bool next(int i, Unit& u) const {
        const long L = (long)i * G + c; if (L >= nwg) return false;
        int wgid = (int)L; { const int q = nwg / NXCD, r = nwg % NXCD, xcd = wgid % NXCD, off = wgid / NXCD; wgid = (xcd < r ? xcd * (q + 1) : r * (q + 1) + (xcd - r) * q) + off; }
        const int nig = WGM * nN, gid = wgid / nig, fm = gid * WGM, gsz = (nM - fm) < WGM ? (nM - fm) : WGM;
        u.pm = fm + ((wgid % nig) % gsz); u.pn = (wgid % nig) / gsz; return true;
    }
};

template <class Epi>
__device__ __forceinline__ void gemm_phase(PG8_LAS unsigned char* lds, const Gemm g, const StaticOrder& S, const Epi& E) {
    const int tid = threadIdx.x, wid = __builtin_amdgcn_readfirstlane(tid >> 6), lane = tid & 63, wr = wid >> 2, wc = wid & 3, fr = lane & 15, fq = lane >> 4;
    const int K = g.K, nt = K / BK;
    unsigned voffA[2], voffB[2];
#pragma unroll
    for (int i = 0; i < 2; ++i) { int R, C; stage_rc(tid * 16 + i * 8192, R, C); const int Rb = Epi::PERM ? ((R & ~31) + perm32(R & 31)) : R;
        voffA[i] = (unsigned)(R * K + C) * 2u; voffB[i] = (unsigned)(Rb * K + C) * 2u; }
    const size_t kstep = (size_t)(BK * 2);
    const size_t hstep = (size_t)HALF * K * 2;
    const size_t tstep = 2 * hstep;
    const unsigned ldsw = (unsigned)wid * 1024u;
    const int aoff = lds_byte(wr * 64 + fr, fq * 8), boff = lds_byte(wc * 32 + fr, fq * 8);
#define PG8_SA(b, h) (((b) * 2 + (h)) * HTB)
#define PG8_SB(b, h) ((4 + (b) * 2 + (h)) * HTB)
#define PG8_STAGE(bufoff, gbase, voff) do { _Pragma("unroll") for (int _i = 0; _i < 2; ++_i) \
        __builtin_amdgcn_global_load_lds((const unsigned*)((const char*)(gbase) + (voff)[_i]), (PG8_LAS unsigned*)(lds + (bufoff) + ldsw + _i * 8192), 16, 0, 0); } while (0)
#define PG8_LDA(dst, b, h) do { _Pragma("unroll") for (int m = 0; m < 4; ++m) _Pragma("unroll") for (int k = 0; k < 2; ++k) dst[m][k] = *(const PG8_LAS bf16x8*)(lds + PG8_SA(b, h) + aoff + m * 2048 + k * 1024); } while (0)
#define PG8_LDB(dst, b, h) do { _Pragma("unroll") for (int n = 0; n < 2; ++n) _Pragma("unroll") for (int k = 0; k < 2; ++k) dst[n][k] = *(const PG8_LAS bf16x8*)(lds + PG8_SB(b, h) + boff + n * 2048 + k * 1024); } while (0)
#define PG8_MMA(ai, bj, At, Bt) do { __builtin_amdgcn_s_setprio(1); _Pragma("unroll") for (int m = 0; m < 4; ++m) _Pragma("unroll") for (int n = 0; n < 2; ++n) _Pragma("unroll") for (int k = 0; k < 2; ++k) \
        acc[ai][bj][m][n] = __builtin_amdgcn_mfma_f32_16x16x32_bf16(Bt[n][k], At[m][k], acc[ai][bj][m][n], 0, 0, 0); __builtin_amdgcn_s_setprio(0); } while (0)
#define PG8_WAIT_V(n) asm volatile("s_waitcnt vmcnt(" #n ")" ::: "memory")
#define PG8_WAIT_L(n) asm volatile("s_waitcnt lgkmcnt(" #n ")" ::: "memory")
#define PG8_BAR __builtin_amdgcn_s_barrier()
#define PG8_SCHED __builtin_amdgcn_sched_barrier(0)
    Unit cur, nxt; int ui = 0;
    if (!S.next(0, cur)) return;
    f32x4 acc[2][2][4][2];
#pragma unroll
    for (int a = 0; a < 2; ++a)
#pragma unroll
        for (int b = 0; b < 2; ++b)
#pragma unroll
            for (int m = 0; m < 4; ++m)
#pragma unroll
                for (int n = 0; n < 2; ++n) acc[a][b][m][n] = (f32x4){0.f, 0.f, 0.f, 0.f};
    bf16x8 At[4][2], B0[2][2], B1[2][2];
    const char* cA = (const char*)g.A + (size_t)cur.pm * tstep; const char* cB = (const char*)g.Bt + (size_t)cur.pn * tstep;
    PG8_STAGE(PG8_SB(0, 0), cB, voffB); PG8_STAGE(PG8_SA(0, 0), cA, voffA); PG8_STAGE(PG8_SB(0, 1), cB + hstep, voffB); PG8_STAGE(PG8_SA(0, 1), cA + hstep, voffA);
    if (wr == 1) PG8_BAR;
    PG8_WAIT_V(4); PG8_BAR;
    PG8_STAGE(PG8_SB(1, 0), cB + kstep, voffB); PG8_STAGE(PG8_SA(1, 0), cA + kstep, voffA); PG8_STAGE(PG8_SB(1, 1), cB + hstep + kstep, voffB);
    PG8_WAIT_V(6); PG8_BAR;
    for (;;) {
        const bool has_next = S.next(ui + 1, nxt);
        const char* nA = has_next ? (const char*)g.A + (size_t)nxt.pm * tstep : cA; const char* nB = has_next ? (const char*)g.Bt + (size_t)nxt.pn * tstep : cB;
        for (int t = 0; t < nt; t += 2) {
            const bool last = (t == nt - 2);
            const char* a1 = cA + (size_t)(t + 1) * kstep;
            const char* a2 = last ? nA : cA + (size_t)(t + 2) * kstep; const char* b2 = last ? nB : cB + (size_t)(t + 2) * kstep;
            const char* a3 = a2 + kstep; const char* b3 = b2 + kstep;
            PG8_LDB(B0, 0, 0); PG8_SCHED; PG8_LDA(At, 0, 0); PG8_STAGE(PG8_SA(1, 1), a1 + hstep, voffA);
            PG8_WAIT_L(8); PG8_BAR; PG8_WAIT_L(0); PG8_MMA(0, 0, At, B0); PG8_BAR; PG8_SCHED;
            PG8_LDB(B1, 0, 1); PG8_STAGE(PG8_SB(0, 0), b2, voffB);
            PG8_BAR; PG8_WAIT_L(0); PG8_MMA(0, 1, At, B1); PG8_BAR;
            PG8_LDA(At, 0, 1); PG8_STAGE(PG8_SA(0, 0), a2, voffA);
            PG8_BAR; PG8_WAIT_L(0); PG8_MMA(1, 0, At, B0); PG8_BAR; PG8_SCHED;
            PG8_STAGE(PG8_SB(0, 1), b2 + hstep, voffB);
            PG8_WAIT_V(6); PG8_BAR; PG8_MMA(1, 1, At, B1); PG8_BAR;
            PG8_LDB(B0, 1, 0); PG8_SCHED; PG8_LDA(At, 1, 0); PG8_STAGE(PG8_SA(0, 1), a2 + hstep, voffA);
            PG8_WAIT_L(8); PG8_BAR; PG8_WAIT_L(0); PG8_MMA(0, 0, At, B0); PG8_BAR; PG8_SCHED;
            PG8_LDB(B1, 1, 1); PG8_STAGE(PG8_SB(1, 0), b3, voffB);
            PG8_BAR; PG8_WAIT_L(0); PG8_MMA(0, 1, At, B1); PG8_BAR;
            PG8_LDA(At, 1, 1); PG8_STAGE(PG8_SA(1, 0), a3, voffA);
            PG8_BAR; PG8_WAIT_L(0); PG8_MMA(1, 0, At, B0); PG8_BAR; PG8_SCHED;
            PG8_STAGE(PG8_SB(1, 1), b3 + hstep, voffB);
            PG8_WAIT_V(6); PG8_BAR; PG8_MMA(1, 1, At, B1); PG8_BAR;
        }
        E(acc, cur, wr, wc, fr, fq);
        if (!has_next) break;
#pragma unroll
        for (int a = 0; a < 2; ++a)
#pragma unroll
            for (int b = 0; b < 2; ++b)
#pragma unroll
                for (int m = 0; m < 4; ++m)
#pragma unroll
                    for (int n = 0; n < 2; ++n) acc[a][b][m][n] = (f32x4){0.f, 0.f, 0.f, 0.f};
        cur = nxt; cA = nA; cB = nB; ++ui;
    }
    PG8_WAIT_V(0);
    if (wr == 0) PG8_BAR;
    PG8_BAR;
#undef PG8_SA
#undef PG8_SB
#undef PG8_STAGE
#undef PG8_LDA
#undef PG8_LDB
#undef PG8_MMA
#undef PG8_WAIT_V
#undef PG8_WAIT_L
#undef PG8_BAR
#undef PG8_SCHED
}
}

struct EpiPlain {
    static constexpr bool PERM = true;
    bf16_t* O; int ldc;
    DI void operator()(const f32x4 (&acc)[2][2][4][2], const pg8::Unit& u, int wr, int wc, int fr, int fq) const {
        const int row0 = u.pm * 256 + wr * 64 + fr, col0 = u.pn * 256 + wc * 32 + 8 * fq;
#pragma unroll
        for (int ai = 0; ai < 2; ++ai)
#pragma unroll
            for (int m = 0; m < 4; ++m) { bf16_t* rowp = O + (size_t)(row0 + ai * 128 + m * 16) * ldc + col0;
#pragma unroll
                for (int bj = 0; bj < 2; ++bj) { const f32x4 v0 = acc[ai][bj][m][0], v1 = acc[ai][bj][m][1];
                    u32x4 w; w.x = cvt_pk_bf16(v0[0], v0[1]); w.y = cvt_pk_bf16(v0[2], v0[3]); w.z = cvt_pk_bf16(v1[0], v1[1]); w.w = cvt_pk_bf16(v1[2], v1[3]);
                    *(u32x4*)(rowp + bj * 128) = w; } }
    }
};
struct EpiRelu2 {
    static constexpr bool PERM = true;
    bf16_t* O; int ldc;
    DI void operator()(const f32x4 (&acc)[2][2][4][2], const pg8::Unit& u, int wr, int wc, int fr, int fq) const {
        const int row0 = u.pm * 256 + wr * 64 + fr, col0 = u.pn * 256 + wc * 32 + 8 * fq;
#pragma unroll
        for (int ai = 0; ai < 2; ++ai)
#pragma unroll
            for (int m = 0; m < 4; ++m) { bf16_t* rowp = O + (size_t)(row0 + ai * 128 + m * 16) * ldc + col0;
#pragma unroll
                for (int bj = 0; bj < 2; ++bj) { f32x4 v0 = acc[ai][bj][m][0], v1 = acc[ai][bj][m][1];
#pragma unroll
                    for (int j = 0; j < 4; ++j) { const float a = fmaxf(v0[j], 0.f), b = fmaxf(v1[j], 0.f); v0[j] = a * a; v1[j] = b * b; }
                    u32x4 w; w.x = cvt_pk_bf16(v0[0], v0[1]); w.y = cvt_pk_bf16(v0[2], v0[3]); w.z = cvt_pk_bf16(v1[0], v1[1]); w.w = cvt_pk_bf16(v1[2], v1[3]);
                    *(u32x4*)(rowp + bj * 128) = w; } }
    }
};
struct EpiRes {
    static constexpr bool PERM = true;
    bf16_t* O; const bf16_t* R;
    DI void operator()(const f32x4 (&acc)[2][2][4][2], const pg8::Unit& u, int wr, int wc, int fr, int fq) const {
        const int row0 = u.pm * 256 + wr * 64 + fr, col0 = u.pn * 256 + wc * 32 + 8 * fq;
#pragma unroll
        for (int ai = 0; ai < 2; ++ai)
#pragma unroll
            for (int m = 0; m < 4; ++m) { const size_t off = (size_t)(row0 + ai * 128 + m * 16) * 1024 + col0;
#pragma unroll
                for (int bj = 0; bj < 2; ++bj) { const f32x4 v0 = acc[ai][bj][m][0], v1 = acc[ai][bj][m][1];
                    const u32x4 rr = *(const u32x4*)(R + off + bj * 128);
                    u32x4 w;
                    w.x = cvt_pk_bf16(ALPHA_C * bf_lo(rr.x) + v0[0], ALPHA_C * bf_hi(rr.x) + v0[1]); w.y = cvt_pk_bf16(ALPHA_C * bf_lo(rr.y) + v0[2], ALPHA_C * bf_hi(rr.y) + v0[3]);
                    w.z = cvt_pk_bf16(ALPHA_C * bf_lo(rr.z) + v1[0], ALPHA_C * bf_hi(rr.z) + v1[1]); w.w = cvt_pk_bf16(ALPHA_C * bf_lo(rr.w) + v1[2], ALPHA_C * bf_hi(rr.w) + v1[3]);
                    *(u32x4*)(O + off + bj * 128) = w; } }
    }
};
struct EpiQKV {
    static constexpr bool PERM = true;
    bf16_t* O; const float* rc; const float* rs;
    DI void operator()(const f32x4 (&acc)[2][2][4][2], const pg8::Unit& u, int wr, int wc, int fr, int fq) const {
        const int row0 = u.pm * 256 + wr * 64 + fr, col0 = u.pn * 256 + wc * 32 + 8 * fq;
        const bool rot = u.pn < 4; const int i0 = 16 * (wc & 1) + 4 * fq;
#pragma unroll
        for (int ai = 0; ai < 2; ++ai)
#pragma unroll
            for (int m = 0; m < 4; ++m) { const int row = row0 + ai * 128 + m * 16; bf16_t* rowp = O + (size_t)row * 3072 + col0;
                f32x4 c4 = (f32x4){1.f, 1.f, 1.f, 1.f}, s4 = (f32x4){0.f, 0.f, 0.f, 0.f};
                if (rot) { const int t = row & (row < MP ? 4095 : 8191); c4 = *(const f32x4*)(rc + t * 32 + i0); s4 = *(const f32x4*)(rs + t * 32 + i0); }
#pragma unroll
                for (int bj = 0; bj < 2; ++bj) { const f32x4 v0 = acc[ai][bj][m][0], v1 = acc[ai][bj][m][1];
                    const f32x4 o0 = v0 * c4 - v1 * s4, o1 = v1 * c4 + v0 * s4;
                    u32x4 w; w.x = cvt_pk_bf16(o0[0], o0[1]); w.y = cvt_pk_bf16(o0[2], o0[3]); w.z = cvt_pk_bf16(o1[0], o1[1]); w.w = cvt_pk_bf16(o1[2], o1[3]);
                    *(u32x4*)(rowp + bj * 128) = w; }
                asm volatile("" ::: "memory"); }
    }
};

DI void transpose_w(const float* __restrict__ W, int K, int N, bf16_t* __restrict__ Wt, int mode, const float* ga, const float* gb, int gw, int nw, int lane) {
    const int nNb = N >> 6, units = nNb * (K >> 6);
    for (int u = gw; u < units; u += nw) {
        const int nb = u % nNb, kb = u / nNb, n = nb * 64 + lane; int src = n; float sc = 1.f;
        if (mode == 1) { if (n < 1024) { const int hd = n >> 6, p = n & 63, j = p >> 3, e = p & 7; src = (hd << 6) + (e < 4 ? 4 * j + e : 32 + 4 * j + (e - 4)); }
            if (n < 512 || (n >= 1536 && n < 2048)) sc = 0.125f; }
        if (mode == 3) sc = 0.0625f;
#pragma unroll
        for (int kk = 0; kk < 8; ++kk) { const int k0 = kb * 64 + kk * 8; float v[8];
#pragma unroll
            for (int j = 0; j < 8; ++j) { float x = W[(size_t)(k0 + j) * N + src] * sc; if (mode == 2) x *= (k0 + j < 512) ? ga[k0 + j] : gb[k0 + j - 512]; v[j] = x; }
            u32x4 w; w.x = cvt_pk_bf16(v[0], v[1]); w.y = cvt_pk_bf16(v[2], v[3]); w.z = cvt_pk_bf16(v[4], v[5]); w.w = cvt_pk_bf16(v[6], v[7]);
            *(u32x4*)(Wt + (size_t)n * K + k0) = w; }
    }
}
DI void phase_prologue(const Params& p, int gw, int nw, int lane) {
    unsigned char* sm = p.out;
    transpose_w(p.w_in, 1024, 3072, (bf16_t*)(sm + SM_WIN), 1, nullptr, nullptr, gw, nw, lane);
    transpose_w(p.w_out, 1024, 1024, (bf16_t*)(sm + SM_WOUT), 2, p.g_mix_a, p.g_mix_b, gw, nw, lane);
    transpose_w(p.w_xq, 1024, 1024, (bf16_t*)(sm + SM_WXQ), 3, nullptr, nullptr, gw, nw, lane);
    transpose_w(p.w_xkv, 1024, 2048, (bf16_t*)(sm + SM_WXKV), 0, nullptr, nullptr, gw, nw, lane);
    transpose_w(p.w_xo, 1024, 1024, (bf16_t*)(sm + SM_WXO), 0, nullptr, nullptr, gw, nw, lane);
    transpose_w(p.w_up, 1024, 4096, (bf16_t*)(sm + SM_WUP), 0, nullptr, nullptr, gw, nw, lane);
    transpose_w(p.w_down, 4096, 1024, (bf16_t*)(sm + SM_WDOWN), 0, nullptr, nullptr, gw, nw, lane);
    { bf16_t* mb = (bf16_t*)(sm + SM_MEMB); const int gt = gw * 64 + lane, nt = nw * 64;
      for (int i = gt; i < NMEM * 1024 / 8; i += nt) { const int e = i * 8; const float* s = e < 4096 * 1024 ? p.mem_prompt + e : p.mem_sample + (e - 4096 * 1024);
          const f32x4 a = *(const f32x4*)s, b = *(const f32x4*)(s + 4); u32x4 w; w.x = cvt_pk_bf16(a[0], a[1]); w.y = cvt_pk_bf16(a[2], a[3]); w.z = cvt_pk_bf16(b[0], b[1]); w.w = cvt_pk_bf16(b[2], b[3]);
          *(u32x4*)(mb + e) = w; }
      float* rc = (float*)(sm + SM_RC); float* rs = (float*)(sm + SM_RS);
      for (int i = gt; i < 8192 * 32; i += nt) { const int t = i >> 5, f = i & 31; const float inv = powf(10000.0f, -(float)f / 32.0f); const float ang = (float)t * inv;
          const double a = (double)ang; const double kq = rint(a * 0.15915494309189535); const float r = (float)(a - kq * 6.283185307179586);
          rc[i] = cosf(r); rs[i] = sinf(r); } }
    bf16_t* XN = (bf16_t*)(p.ws + WS_XN);
    const f32x4 g0 = *(const f32x4*)(p.ln_in_g + lane * 8), g1 = *(const f32x4*)(p.ln_in_g + lane * 8 + 4), g2 = *(const f32x4*)(p.ln_in_g + 512 + lane * 8), g3 = *(const f32x4*)(p.ln_in_g + 516 + lane * 8);
    const f32x4 b0 = *(const f32x4*)(p.ln_in_b + lane * 8), b1 = *(const f32x4*)(p.ln_in_b + lane * 8 + 4), b2 = *(const f32x4*)(p.ln_in_b + 512 + lane * 8), b3 = *(const f32x4*)(p.ln_in_b + 516 + lane * 8);
    for (int row = gw; row < MTOK; row += nw) {
        const float* x = row < MP ? p.x_prompt + (size_t)row * 1024 : p.x_sample + (size_t)(row - MP) * 1024;
        f32x4 v0 = *(const f32x4*)(x + lane * 8), v1 = *(const f32x4*)(x + lane * 8 + 4), v2 = *(const f32x4*)(x + 512 + lane * 8), v3 = *(const f32x4*)(x + 516 + lane * 8);
        f32x4 t = (v0 + v1) + (v2 + v3); const float mean = wave_sum((t[0] + t[1]) + (t[2] + t[3])) * (1.f / 1024.f);
        v0 -= mean; v1 -= mean; v2 -= mean; v3 -= mean; t = (v0 * v0 + v1 * v1) + (v2 * v2 + v3 * v3);
        const float rstd = rsqrtf(wave_sum((t[0] + t[1]) + (t[2] + t[3])) * (1.f / 1024.f) + LN_EPS_C);
        v0 = v0 * rstd * g0 + b0; v1 = v1 * rstd * g1 + b1; v2 = v2 * rstd * g2 + b2; v3 = v3 * rstd * g3 + b3;
        u32x4 w; w.x = cvt_pk_bf16(v0[0], v0[1]); w.y = cvt_pk_bf16(v0[2], v0[3]); w.z = cvt_pk_bf16(v1[0], v1[1]); w.w = cvt_pk_bf16(v1[2], v1[3]);
        *(u32x4*)(XN + (size_t)row * 1024 + lane * 8) = w;
        w.x = cvt_pk_bf16(v2[0], v2[1]); w.y = cvt_pk_bf16(v2[2], v2[3]); w.z = cvt_pk_bf16(v3[0], v3[1]); w.w = cvt_pk_bf16(v3[2], v3[3]);
        *(u32x4*)(XN + (size_t)row * 1024 + 512 + lane * 8) = w;
    }
}

template <bool OUTF32>
DI void phase_ln(const bf16_t* __restrict__ Z, const float* __restrict__ gam, const float* __restrict__ bet, bf16_t* __restrict__ X, float* __restrict__ OF, int gw, int nw, int lane) {
    const f32x4 g0 = *(const f32x4*)(gam + lane * 8), g1 = *(const f32x4*)(gam + lane * 8 + 4), g2 = *(const f32x4*)(gam + 512 + lane * 8), g3 = *(const f32x4*)(gam + 516 + lane * 8);
    const f32x4 b0 = *(const f32x4*)(bet + lane * 8), b1 = *(const f32x4*)(bet + lane * 8 + 4), b2 = *(const f32x4*)(bet + 512 + lane * 8), b3 = *(const f32x4*)(bet + 516 + lane * 8);
#pragma unroll 2
    for (int row = gw; row < MTOK; row += nw) {
        const u32x4 za = *(const u32x4*)(Z + (size_t)row * 1024 + lane * 8), zb = *(const u32x4*)(Z + (size_t)row * 1024 + 512 + lane * 8);
        f32x4 v0 = (f32x4){bf_lo(za.x), bf_hi(za.x), bf_lo(za.y), bf_hi(za.y)}, v1 = (f32x4){bf_lo(za.z), bf_hi(za.z), bf_lo(za.w), bf_hi(za.w)};
        f32x4 v2 = (f32x4){bf_lo(zb.x), bf_hi(zb.x), bf_lo(zb.y), bf_hi(zb.y)}, v3 = (f32x4){bf_lo(zb.z), bf_hi(zb.z), bf_lo(zb.w), bf_hi(zb.w)};
        f32x4 t = (v0 + v1) + (v2 + v3); const float mean = wave_sum((t[0] + t[1]) + (t[2] + t[3])) * (1.f / 1024.f);
        v0 -= mean; v1 -= mean; v2 -= mean; v3 -= mean; t = (v0 * v0 + v1 * v1) + (v2 * v2 + v3 * v3);
        const float rstd = rsqrtf(wave_sum((t[0] + t[1]) + (t[2] + t[3])) * (1.f / 1024.f) + LN_EPS_C);
        v0 = v0 * rstd * g0 + b0; v1 = v1 * rstd * g1 + b1; v2 = v2 * rstd * g2 + b2; v3 = v3 * rstd * g3 + b3;
        if (OUTF32) { float* o = OF + (size_t)row * 1024; *(f32x4*)(o + lane * 8) = v0; *(f32x4*)(o + lane * 8 + 4) = v1; *(f32x4*)(o + 512 + lane * 8) = v2; *(f32x4*)(o + 516 + lane * 8) = v3; }
        else { u32x4 w; w.x = cvt_pk_bf16(v0[0], v0[1]); w.y = cvt_pk_bf16(v0[2], v0[3]); w.z = cvt_pk_bf16(v1[0], v1[1]); w.w = cvt_pk_bf16(v1[2], v1[3]);
            *(u32x4*)(X + (size_t)row * 1024 + lane * 8) = w;
            w.x = cvt_pk_bf16(v2[0], v2[1]); w.y = cvt_pk_bf16(v2[2], v2[3]); w.z = cvt_pk_bf16(v3[0], v3[1]); w.w = cvt_pk_bf16(v3[2], v3[3]);
            *(u32x4*)(X + (size_t)row * 1024 + 512 + lane * 8) = w; }
    }
}

constexpr int VROW = 144;
constexpr int VWAVE = 64 * VROW;
constexpr int LDS_RMS = 8 * VWAVE;
constexpr int LDS_RPB = LDS_RMS + 1024;

DI void tr_read8(unsigned addr, s16x4 (&r)[8]) {
    asm volatile("s_waitcnt lgkmcnt(0)\n\t"
                 "ds_read_b64_tr_b16 %0, %8 offset:0\n\t" "ds_read_b64_tr_b16 %1, %8 offset:2304\n\t"
                 "ds_read_b64_tr_b16 %2, %8 offset:32\n\t" "ds_read_b64_tr_b16 %3, %8 offset:2336\n\t"
                 "ds_read_b64_tr_b16 %4, %8 offset:64\n\t" "ds_read_b64_tr_b16 %5, %8 offset:2368\n\t"
                 "ds_read_b64_tr_b16 %6, %8 offset:96\n\t" "ds_read_b64_tr_b16 %7, %8 offset:2400\n\t"
                 "s_waitcnt lgkmcnt(0)"
                 : "=&v"(r[0]), "=&v"(r[1]), "=&v"(r[2]), "=&v"(r[3]), "=&v"(r[4]), "=&v"(r[5]), "=&v"(r[6]), "=&v"(r[7]) : "v"(addr) : "memory");
}

template <int NO>
DI void softmax_chunk(f32x4 (&s)[4], float& m, float& l, f32x4 (&o)[NO], bf16x8 (&pf)[2]) {
    float mx = fmaxf(fmaxf(fmaxf(s[0][0], s[0][1]), fmaxf(s[0][2], s[0][3])), fmaxf(fmaxf(s[1][0], s[1][1]), fmaxf(s[1][2], s[1][3])));
    mx = fmaxf(mx, fmaxf(fmaxf(fmaxf(s[2][0], s[2][1]), fmaxf(s[2][2], s[2][3])), fmaxf(fmaxf(s[3][0], s[3][1]), fmaxf(s[3][2], s[3][3]))));
    mx = fmaxf(mx, __shfl_xor(mx, 16)); mx = fmaxf(mx, __shfl_xor(mx, 32));
    const float mn = fmaxf(m, mx), alpha = __builtin_amdgcn_exp2f((m - mn) * LOG2E_C), nb = -mn * LOG2E_C; m = mn;
    float ps = 0.f;
#pragma unroll
    for (int kt = 0; kt < 4; ++kt)
#pragma unroll
        for (int e = 0; e < 4; ++e) { const float pv = __builtin_amdgcn_exp2f(s[kt][e] * LOG2E_C + nb); s[kt][e] = pv; ps += pv; }
    l = l * alpha + ps;
#pragma unroll
    for (int c = 0; c < NO; ++c) o[c] *= alpha;
#pragma unroll
    for (int pr = 0; pr < 2; ++pr) { u32x4 w; w.x = cvt_pk_bf16(s[2 * pr][0], s[2 * pr][1]); w.y = cvt_pk_bf16(s[2 * pr][2], s[2 * pr][3]);
        w.z = cvt_pk_bf16(s[2 * pr + 1][0], s[2 * pr + 1][1]); w.w = cvt_pk_bf16(s[2 * pr + 1][2], s[2 * pr + 1][3]); pf[pr] = __builtin_bit_cast(bf16x8, w); }
}

template <int NCH, class Tok, class Score>
DI void attn64_run(const bf16_t* __restrict__ Kp, const bf16_t* __restrict__ Vp, const bf16x8 q0, const bf16x8 q1, unsigned char* vl, int lane, f32x4 (&o)[4], float& m, float& l, Tok tok, Score score) {
    const int fr = lane & 15, fq = lane >> 4;
    const unsigned vaddr = (unsigned)(size_t)vl + (unsigned)((4 * fq + (fr >> 2)) * VROW + (fr & 3) * 8);
    unsigned char* vw = vl + (lane >> 3) * VROW + (lane & 7) * 16;
    bf16x8 kf[4][2]; u32x4 vr[8];
#pragma unroll
    for (int kt = 0; kt < 4; ++kt) { const bf16_t* kp = Kp + tok(0, 16 * kt + fr) * 3072 + 8 * fq; kf[kt][0] = *(const bf16x8*)kp; kf[kt][1] = *(const bf16x8*)(kp + 32); }
#pragma unroll
    for (int it = 0; it < 8; ++it) vr[it] = *(const u32x4*)(Vp + tok(0, 8 * it + (lane >> 3)) * 3072 + 8 * (lane & 7));
#pragma unroll 1
    for (int c = 0; c < NCH; ++c) {
        bf16x8 kc[4][2]; u32x4 vc[8];
#pragma unroll
        for (int kt = 0; kt < 4; ++kt) { kc[kt][0] = kf[kt][0]; kc[kt][1] = kf[kt][1]; }
#pragma unroll
        for (int it = 0; it < 8; ++it) vc[it] = vr[it];
        if (c + 1 < NCH) {
#pragma unroll
            for (int kt = 0; kt < 4; ++kt) { const bf16_t* kp = Kp + tok(c + 1, 16 * kt + fr) * 3072 + 8 * fq; kf[kt][0] = *(const bf16x8*)kp; kf[kt][1] = *(const bf16x8*)(kp + 32); }
#pragma unroll
            for (int it = 0; it < 8; ++it) vr[it] = *(const u32x4*)(Vp + tok(c + 1, 8 * it + (lane >> 3)) * 3072 + 8 * (lane & 7));
        }
        f32x4 s[4];
#pragma unroll
        for (int kt = 0; kt < 4; ++kt) { s[kt] = __builtin_amdgcn_mfma_f32_16x16x32_bf16(kc[kt][0], q0, (f32x4){0.f, 0.f, 0.f, 0.f}, 0, 0, 0); s[kt] = __builtin_amdgcn_mfma_f32_16x16x32_bf16(kc[kt][1], q1, s[kt], 0, 0, 0); }
#pragma unroll
        for (int kt = 0; kt < 4; ++kt)
#pragma unroll
            for (int e = 0; e < 4; ++e) s[kt][e] = score(c, s[kt][e], kt, e);
        bf16x8 pf[2];
        softmax_chunk<4>(s, m, l, o, pf);
#pragma unroll
        for (int it = 0; it < 8; ++it) *(u32x4*)(vw + it * 8 * VROW) = vc[it];
#pragma unroll
        for (int pr = 0; pr < 2; ++pr) { s16x4 t[8]; tr_read8(vaddr + pr * 32 * VROW, t);
#pragma unroll
            for (int dc = 0; dc < 4; ++dc) { const bf16x8 vf = __builtin_shufflevector(t[2 * dc], t[2 * dc + 1], 0, 1, 2, 3, 4, 5, 6, 7); o[dc] = __builtin_amdgcn_mfma_f32_16x16x32_bf16(vf, pf[pr], o[dc], 0, 0, 0); } }
    }
}

DI void attn64_finish(f32x4 (&o)[4], float l, float* rms, int& par, int wid, int lane, bf16_t* __restrict__ dst  ) {
    const int fr = lane & 15, fq = lane >> 4;
    l += __shfl_xor(l, 16); l += __shfl_xor(l, 32);
    const float inv = 1.0f / l; float ss = 0.f;
#pragma unroll
    for (int c = 0; c < 4; ++c) { o[c] *= inv; ss += (o[c][0] * o[c][0] + o[c][1] * o[c][1]) + (o[c][2] * o[c][2] + o[c][3] * o[c][3]); }
    ss += __shfl_xor(ss, 16); ss += __shfl_xor(ss, 32);
    float* rb = rms + par * 128;
    if (fq == 0) rb[wid * 16 + fr] = ss;
    __syncthreads();
    float tot = 0.f;
#pragma unroll
    for (int w = 0; w < 8; ++w) tot += rb[w * 16 + fr];
    const float rstd = rsqrtf(tot * (1.f / 512.f) + LN_EPS_C);
#pragma unroll
    for (int c = 0; c < 4; ++c) { u32x2 w; w.x = cvt_pk_bf16(o[c][0] * rstd, o[c][1] * rstd); w.y = cvt_pk_bf16(o[c][2] * rstd, o[c][3] * rstd); *(u32x2*)(dst + 16 * c + 4 * fq) = w; }
    par ^= 1;
}

DI void phase_attn(const Params& p, unsigned char* shm, int wid, int lane) {
    const bf16_t* QKV = (const bf16_t*)(p.ws + WS_QKV); bf16_t* O = (bf16_t*)(p.out + OUT_O);
    const int fr = lane & 15, fq = lane >> 4, h = wid;
    unsigned char* vl = shm + wid * VWAVE; float* rms = (float*)(shm + LDS_RMS); float* rpbs = (float*)(shm + LDS_RPB);
    for (int i = threadIdx.x; i < 8 * 465; i += 512) rpbs[i] = p.rpb[i];
    __syncthreads();
    int par = 0;
    for (int item = blockIdx.x; item < MTOK / 256; item += gridDim.x) {
        const int row_base = item * 256; const int T = row_base < MP ? 4096 : 8192; const int bb = row_base < MP ? (row_base & ~4095) : MP + ((row_base - MP) & ~8191); const int t0 = row_base - bb;
        const bf16_t* Kp = QKV + 512 + h * 64; const bf16_t* Vp = QKV + 1024 + h * 64;
#pragma unroll 1
        for (int r = 0; r < 16; ++r) {
            const int tr = t0 + r; const size_t qrow = (size_t)(bb + tr + 16 * fr);
            const bf16_t* qp = QKV + qrow * 3072 + h * 64 + 8 * fq; const bf16x8 q0 = *(const bf16x8*)qp, q1 = *(const bf16x8*)(qp + 32);
            auto tok = [&](int c, int k) -> size_t { const int seg = c < 6 ? 0 : (c < 9 ? 1 : 2), sh = seg * 2, c0 = seg == 0 ? 0 : (seg == 1 ? 6 : 9);
                const int jq0 = tr >> sh, rd = tr & ((1 << sh) - 1), L = T >> sh; int jk = jq0 - 64 + 64 * (c - c0) + k; jk = jk < 0 ? 0 : (jk > L - 1 ? L - 1 : jk); return (size_t)(bb + (jk << sh) + rd); };
            auto score = [&](int c, float s, int kt, int e) -> float { const int seg = c < 6 ? 0 : (c < 9 ? 1 : 2), sh = seg * 2, c0 = seg == 0 ? 0 : (seg == 1 ? 6 : 9);
                const int jq0 = tr >> sh, L = T >> sh, stride = 16 >> sh; const int jk = jq0 - 64 + 64 * (c - c0) + 4 * fq + 16 * kt + e; const int d64 = jk - (jq0 + stride * fr) + 64;
                return ((unsigned)jk < (unsigned)L && (unsigned)d64 <= 128u) ? s : -INFINITY; };
            f32x4 o[4] = {{0.f, 0.f, 0.f, 0.f}, {0.f, 0.f, 0.f, 0.f}, {0.f, 0.f, 0.f, 0.f}, {0.f, 0.f, 0.f, 0.f}}; float m = -1e30f, l = 0.f;
            attn64_run<12>(Kp, Vp, q0, q1, vl, lane, o, m, l, tok, score);
            attn64_finish(o, l, rms, par, wid, lane, O + qrow * 1024 + h * 64);
        }
    }
    for (int item = blockIdx.x; item < MTOK / 64; item += gridDim.x) {
        const int row_base = item * 64; const int T = row_base < MP ? 4096 : 8192; const int bb = row_base < MP ? (row_base & ~4095) : MP + ((row_base - MP) & ~8191);
        const int rows = T >> 6, rq = (row_base - bb) >> 6; int rs = rq - 4; rs = rs < 0 ? 0 : (rs > rows - 8 ? rows - 8 : rs);
        const bf16_t* Kp = QKV + 2048 + h * 64; const bf16_t* Vp = QKV + 2560 + h * 64;
#pragma unroll 1
        for (int cgp = 0; cgp < 4; ++cgp) {
            const int c0 = 16 * cgp, cb = cgp == 0 ? 0 : (cgp == 1 ? 8 : (cgp == 2 ? 24 : 32));
            const size_t qrow = (size_t)(row_base + c0 + fr);
            const bf16_t* qp = QKV + qrow * 3072 + 1536 + h * 64 + 8 * fq; const bf16x8 q0 = *(const bf16x8*)qp, q1 = *(const bf16x8*)(qp + 32);
            const int qc = c0 + fr; int cs = qc - 8; cs = cs < 0 ? 0 : (cs > 48 ? 48 : cs);
            auto tok = [&](int c, int k) -> size_t { return (size_t)(bb + (rs + 2 * c + (k >> 5)) * 64 + cb + (k & 31)); };
            auto score = [&](int c, float s, int kt, int e) -> float { const int krow = rs + 2 * c + (kt >> 1), kcol = cb + 16 * (kt & 1) + 4 * fq + e; int dc = kcol - qc; dc = dc < -15 ? -15 : (dc > 15 ? 15 : dc);
                const float bias = rpbs[h * 465 + (krow - rq + 7) * 31 + dc + 15]; return ((unsigned)(kcol - cs) < 16u) ? s + bias : -INFINITY; };
            f32x4 o[4] = {{0.f, 0.f, 0.f, 0.f}, {0.f, 0.f, 0.f, 0.f}, {0.f, 0.f, 0.f, 0.f}, {0.f, 0.f, 0.f, 0.f}}; float m = -1e30f, l = 0.f;
            attn64_run<4>(Kp, Vp, q0, q1, vl, lane, o, m, l, tok, score);
            attn64_finish(o, l, rms, par, wid, lane, O + qrow * 1024 + 512 + h * 64);
        }
    }
    __syncthreads();
}

DI void phase_xattn(const Params& p, int wid, int lane) {
    const bf16_t* QX = (const bf16_t*)(p.ws + WS_QX); const bf16_t* KM = (const bf16_t*)(p.out + SM_KM); const bf16_t* VTM = (const bf16_t*)(p.out + SM_VTM); bf16_t* OC = (bf16_t*)(p.ws + WS_OC);
    const int fr = lane & 15, fq = lane >> 4;
    for (int bitem = blockIdx.x; bitem < (MTOK / 128) * 4; bitem += gridDim.x) {
        const int rb = bitem >> 2, h = bitem & 3, row0 = rb * 128 + wid * 16;
        const int gb = row0 < MP ? (row0 >> 12) : 16 + ((row0 - MP) >> 13);
        const bf16_t* Kp = KM + (size_t)(gb * 256 + fr) * 1024 + h * 256 + 8 * fq;
        const bf16_t* Vp = VTM + (size_t)(h * 256 + fr) * NMEM + gb * 256 + 4 * fq;
        const bf16_t* qp = QX + (size_t)(row0 + fr) * 1024 + h * 256 + 8 * fq;
        bf16x8 qf[8];
#pragma unroll
        for (int ks = 0; ks < 8; ++ks) qf[ks] = *(const bf16x8*)(qp + 32 * ks);
        f32x4 o[16];
#pragma unroll
        for (int dc = 0; dc < 16; ++dc) o[dc] = (f32x4){0.f, 0.f, 0.f, 0.f};
        float m = -1e30f, l = 0.f;
#pragma unroll 1
        for (int c = 0; c < 4; ++c) {
            f32x4 s[4];
#pragma unroll
            for (int kt = 0; kt < 4; ++kt) { s[kt] = (f32x4){0.f, 0.f, 0.f, 0.f};
#pragma unroll
                for (int ks = 0; ks < 8; ++ks) { const bf16x8 kf = *(const bf16x8*)(Kp + (size_t)(64 * c + 16 * kt) * 1024 + 32 * ks); s[kt] = __builtin_amdgcn_mfma_f32_16x16x32_bf16(kf, qf[ks], s[kt], 0, 0, 0); } }
            bf16x8 pf[2];
            softmax_chunk<16>(s, m, l, o, pf);
#pragma unroll
            for (int pr = 0; pr < 2; ++pr)
#pragma unroll
                for (int dc = 0; dc < 16; ++dc) { const bf16_t* vp = Vp + (size_t)(16 * dc) * NMEM + 64 * c + 32 * pr; const s16x4 lo = *(const s16x4*)vp, hi = *(const s16x4*)(vp + 16);
                    const bf16x8 vf = __builtin_shufflevector(lo, hi, 0, 1, 2, 3, 4, 5, 6, 7); o[dc] = __builtin_amdgcn_mfma_f32_16x16x32_bf16(vf, pf[pr], o[dc], 0, 0, 0); }
        }
        l += __shfl_xor(l, 16); l += __shfl_xor(l, 32);
        const float inv = 1.0f / l; bf16_t* dst = OC + (size_t)(row0 + fr) * 1024 + h * 256 + 4 * fq;
#pragma unroll
        for (int dc = 0; dc < 16; ++dc) { u32x2 w; w.x = cvt_pk_bf16(o[dc][0] * inv, o[dc][1] * inv); w.y = cvt_pk_bf16(o[dc][2] * inv, o[dc][3] * inv); *(u32x2*)(dst + 16 * dc) = w; }
    }
}

constexpr int LDS_BYTES = pg8::STAGE_BYTES;
constexpr int NPHASE = 14;

__global__ void __launch_bounds__(512, 2) fwd_megakernel(const Params p) {
    extern __shared__ __attribute__((aligned(16))) unsigned char shm[];
    PG8_LAS unsigned char* lds = (PG8_LAS unsigned char*)shm;
    const int tid = threadIdx.x, wid = __builtin_amdgcn_readfirstlane(tid >> 6), lane = tid & 63;
    const int G = gridDim.x, gw = blockIdx.x * 8 + wid, nw = G * 8;
    unsigned char* ws = p.ws; unsigned char* sm = p.out;
    const int lo = p.ph_lo, hi = p.ph_hi;
#define IN(k) (((PH_MASK >> (k)) & 1) && lo <= (k) && (k) < hi)
#define SEAM(k) do { if ((k) + 1 < hi) { __threadfence(); cg::this_grid().sync(); } } while (0)
    if (IN(0)) { phase_prologue(p, gw, nw, lane); } if (lo <= 0 && 0 < hi) SEAM(0);
    if (IN(1)) {
        { pg8::StaticOrder S; pg8::Gemm g{(const bf16_t*)(ws + WS_XN), (const bf16_t*)(sm + SM_WIN), MTOK, 3072, 1024}; S.init(g.M, g.N, G, blockIdx.x);
          EpiQKV E{(bf16_t*)(ws + WS_QKV), (const float*)(sm + SM_RC), (const float*)(sm + SM_RS)}; pg8::gemm_phase(lds, g, S, E); }
#if !defined(NO_KV)
        { pg8::StaticOrder S; pg8::Gemm g{(const bf16_t*)(sm + SM_MEMB), (const bf16_t*)(sm + SM_WXKV), NMEM, 1024, 1024}; S.init(g.M, g.N, G, blockIdx.x);
          EpiPlain E{(bf16_t*)(sm + SM_KM), 1024}; pg8::gemm_phase(lds, g, S, E); }
        { pg8::StaticOrder S; pg8::Gemm g{(const bf16_t*)(sm + SM_WXKV) + (size_t)1024 * 1024, (const bf16_t*)(sm + SM_MEMB), 1024, NMEM, 1024}; S.init(g.M, g.N, G, (blockIdx.x + 128) % G);
          EpiPlain E{(bf16_t*)(sm + SM_VTM), NMEM}; pg8::gemm_phase(lds, g, S, E); }
#endif
    } if (lo <= 1 && 1 < hi) SEAM(1);
    if (IN(2)) { phase_attn(p, shm, wid, lane); } if (lo <= 2 && 2 < hi) SEAM(2);
    if (IN(3)) { pg8::StaticOrder S; pg8::Gemm g{(const bf16_t*)(sm + OUT_O), (const bf16_t*)(sm + SM_WOUT), MTOK, 1024, 1024}; S.init(g.M, g.N, G, blockIdx.x);
        EpiRes E{(bf16_t*)(ws + WS_Z1), (const bf16_t*)(ws + WS_XN)}; pg8::gemm_phase(lds, g, S, E); } if (lo <= 3 && 3 < hi) SEAM(3);
    if (IN(4)) { phase_ln<false>((const bf16_t*)(ws + WS_Z1), p.ln1_g, p.ln1_b, (bf16_t*)(ws + WS_X1), nullptr, gw, nw, lane); } if (lo <= 4 && 4 < hi) SEAM(4);
    if (IN(5)) { pg8::StaticOrder S; pg8::Gemm g{(const bf16_t*)(ws + WS_X1), (const bf16_t*)(sm + SM_WXQ), MTOK, 1024, 1024}; S.init(g.M, g.N, G, blockIdx.x);
        EpiPlain E{(bf16_t*)(ws + WS_QX), 1024}; pg8::gemm_phase(lds, g, S, E); } if (lo <= 5 && 5 < hi) SEAM(5);
    if (IN(6)) { phase_xattn(p, wid, lane); } if (lo <= 6 && 6 < hi) SEAM(6);
    if (IN(7)) { pg8::StaticOrder S; pg8::Gemm g{(const bf16_t*)(ws + WS_OC), (const bf16_t*)(sm + SM_WXO), MTOK, 1024, 1024}; S.init(g.M, g.N, G, blockIdx.x);
        EpiRes E{(bf16_t*)(ws + WS_Z2), (const bf16_t*)(ws + WS_X1)}; pg8::gemm_phase(lds, g, S, E); } if (lo <= 7 && 7 < hi) SEAM(7);
    if (IN(8)) { phase_ln<false>((const bf16_t*)(ws + WS_Z2), p.ln2_g, p.ln2_b, (bf16_t*)(ws + WS_X2), nullptr, gw, nw, lane); } if (lo <= 8 && 8 < hi) SEAM(8);
#define UPDOWN(ch) do { const size_t r0 = (size_t)(ch) * MP; \
        if (IN(9 + 2 * (ch))) { pg8::StaticOrder S; pg8::Gemm g{(const bf16_t*)(ws + WS_X2) + r0 * 1024, (const bf16_t*)(sm + SM_WUP), MP, 4096, 1024}; S.init(g.M, g.N, G, blockIdx.x); \
            EpiRelu2 E{(bf16_t*)(ws + WS_H), 4096}; pg8::gemm_phase(lds, g, S, E); } if (lo <= 9 + 2 * (ch) && 9 + 2 * (ch) < hi) SEAM(9 + 2 * (ch)); \
        if (IN(10 + 2 * (ch))) { pg8::StaticOrder S; pg8::Gemm g{(const bf16_t*)(ws + WS_H), (const bf16_t*)(sm + SM_WDOWN), MP, 1024, 4096}; S.init(g.M, g.N, G, blockIdx.x); \
            EpiRes E{(bf16_t*)(ws + WS_Z3) + r0 * 1024, (const bf16_t*)(ws + WS_X2) + r0 * 1024}; pg8::gemm_phase(lds, g, S, E); } if (lo <= 10 + 2 * (ch) && 10 + 2 * (ch) < hi) SEAM(10 + 2 * (ch)); } while (0)
    UPDOWN(0);
    UPDOWN(1);
    if (IN(13)) { phase_ln<true>((const bf16_t*)(ws + WS_Z3), p.ln3_g, p.ln3_b, nullptr, (float*)p.out, gw, nw, lane); }
}

extern "C" void kernel_launch(void* const* d_in, const int* in_sizes, int n_in, void* d_out, int out_size, void* d_ws, size_t ws_size, hipStream_t stream) {
    static int grid = 0;
    if (grid == 0) {
        if (n_in != 22 || ws_size < WS_NEED || (size_t)out_size != (size_t)MTOK * 1024) { fprintf(stderr, "kernel_launch: unexpected shapes (n_in %d, ws %zu, out %d); nothing launched\n", n_in, ws_size, out_size); grid = -1; return; }
        int dev = 0, cus = 0, per_cu = 0;
        hipGetDevice(&dev); hipDeviceGetAttribute(&cus, hipDeviceAttributeMultiprocessorCount, dev);
        if (hipFuncSetAttribute((const void*)fwd_megakernel, hipFuncAttributeMaxDynamicSharedMemorySize, LDS_BYTES) != hipSuccess) { fprintf(stderr, "kernel_launch: hipFuncSetAttribute failed\n"); grid = -1; return; }
        if (hipOccupancyMaxActiveBlocksPerMultiprocessor(&per_cu, (const void*)fwd_megakernel, 512, LDS_BYTES) != hipSuccess || per_cu < 1) { fprintf(stderr, "kernel_launch: occupancy query says %d\n", per_cu); per_cu = 1; }
        (void)hipGetLastError();
        grid = cus * 1;
    }
    if (grid < 0) return;
    Params p{};
    const float** pp = (const float**)&p;
    for (int i = 0; i < 22; ++i) pp[i] = (const float*)d_in[i];
    p.out = (unsigned char*)d_out; p.ws = (unsigned char*)d_ws;
#if N_LAUNCHES == 1
    p.ph_lo = 0; p.ph_hi = NPHASE;
    void* args[] = {(void*)&p};
    hipError_t e = hipLaunchCooperativeKernel((const void*)fwd_megakernel, dim3(grid), dim3(512), args, LDS_BYTES, stream);
    if (e != hipSuccess) fprintf(stderr, "cooperative launch failed: %s (grid %d)\n", hipGetErrorString(e), grid);
#else
    for (int ph = 0; ph < NPHASE; ++ph) { p.ph_lo = ph; p.ph_hi = ph + 1; hipLaunchKernelGGL(fwd_megakernel, dim3(grid), dim3(512), LDS_BYTES, stream, p); }
#endif
}
```

```cpp
#include <hip/hip_runtime.h>
#include <hip/hip_cooperative_groups.h>
#include <cstdio>
namespace cg = cooperative_groups;

#define DI __device__ __forceinline__
#define PG8_LAS __attribute__((address_space(3)))
typedef unsigned short bf16_t;
typedef short bf16x8 __attribute__((ext_vector_type(8)));
typedef short s16x4 __attribute__((ext_vector_type(4)));
typedef float f32x4 __attribute__((ext_vector_type(4)));
typedef unsigned u32x4 __attribute__((ext_vector_type(4)));
typedef unsigned u32x2 __attribute__((ext_vector_type(2)));

#ifndef NO_P1
#define NO_P1 0
#endif
#ifndef NO_P2
#define NO_P2 0
#endif
#ifndef PH_MASK
#define PH_MASK 0xffff
#endif
#ifndef N_LAUNCHES
#define N_LAUNCHES 1
#endif

constexpr int MTOK = 131072, MP = 65536, NMEM = 6144;
constexpr float ALPHA_C = 1.189207115002721f, LN_EPS_C = 1e-5f, LOG2E_C = 1.4426950408889634f;
constexpr size_t MiB = (size_t)1 << 20;
constexpr size_t WS_XN = 0, WS_QKV = 256 * MiB, WS_Z1 = 256 * MiB, WS_QX = 512 * MiB, WS_OC = 768 * MiB, WS_X1 = 0, WS_Z2 = 256 * MiB, WS_X2 = 512 * MiB, WS_H = 0, WS_Z3 = 768 * MiB;
constexpr size_t WS_NEED = 1024 * MiB;
constexpr size_t WS_BAR2 = 512 * MiB;
constexpr size_t OUT_O = 0, OUT_SM = 256 * MiB;
constexpr size_t SM_WIN = OUT_SM, SM_WOUT = SM_WIN + 6 * MiB, SM_WXQ = SM_WOUT + 2 * MiB, SM_WXKV = SM_WXQ + 2 * MiB, SM_WXO = SM_WXKV + 4 * MiB, SM_WUP = SM_WXO + 2 * MiB,
                 SM_WDOWN = SM_WUP + 8 * MiB, SM_MEMB = SM_WDOWN + 8 * MiB, SM_KM = SM_MEMB + 12 * MiB, SM_VTM = SM_KM + 12 * MiB, SM_RC = SM_VTM + 12 * MiB, SM_RS = SM_RC + 1 * MiB, SM_ML = SM_RS + 1 * MiB  , SM_BAR = SM_ML + 8 * MiB  , SM_SMALL = SM_BAR + 65536  ;
constexpr int SS_RPB = 0, SS_LN1G = 4096, SS_LN1B = 5120, SS_LN2G = 6144, SS_LN2B = 7168, SS_TOTAL = 8192;

struct Params {
    const float *x_prompt, *x_sample, *mem_prompt, *mem_sample, *ln_in_g, *ln_in_b, *w_in, *rpb, *g_mix_a, *g_mix_b, *w_out, *ln1_g, *ln1_b, *w_xq, *w_xkv, *w_xo, *ln2_g, *ln2_b, *w_up, *w_down, *ln3_g, *ln3_b;
    unsigned char* out; unsigned char* ws; int ph_lo, ph_hi;
};

typedef __bf16 bf16x2n __attribute__((ext_vector_type(2)));
typedef float f32x2n __attribute__((ext_vector_type(2)));
DI unsigned cvt_pk_bf16(float lo, float hi) { const f32x2n v = {lo, hi}; const bf16x2n b = __builtin_convertvector(v, bf16x2n); return __builtin_bit_cast(unsigned, b); }
DI float bf_lo(unsigned w) { return __uint_as_float(w << 16); }
DI float bf_hi(unsigned w) { return __uint_as_float(w & 0xffff0000u); }
DI float wave_sum(float v) { for (int o = 32; o >= 1; o >>= 1) v += __shfl_xor(v, o); return v; }

namespace pg8 {
constexpr int BM = 256, BK = 64, HALF = 128, HTB = HALF * BK * 2, STAGE_BYTES = 8 * HTB, NXCD = 8, WGM = 8;
__host__ __device__ __forceinline__ int lds_byte(int r, int c) { const int st = (r >> 4) * 2 + (c >> 5), rr = r & 15, cc = c & 31, ob = rr * 64 + cc * 2; return st * 1024 + (ob ^ (((ob >> 9) & 1) << 5)); }
__host__ __device__ __forceinline__ void stage_rc(int b, int& R, int& C) { const int st = b / 1024, sb = b % 1024, swz = sb ^ (((sb >> 9) & 1) << 5); R = (st >> 1) * 16 + swz / 64; C = (st & 1) * 32 + (swz % 64) / 2; }
__host__ __device__ __forceinline__ int perm32(int rho) { const int n = rho >> 4, i = rho & 15; return 8 * (i >> 2) + 4 * n + (i & 3); }
struct Unit { int pm, pn; };
struct Gemm { const bf16_t* A; const bf16_t* Bt; int M, N, K; };
struct StaticOrder {
    int nM, nN, nwg, G, c;
    __device__ void init(int M, int N, int G_, int c_) { nM = M / BM; nN = N / BM; nwg = nM * nN; G = G_; c = c_; }
    __device__ bool next(int i, Unit& u) const {
        const long L = (long)i * G + c; if (L >= nwg) return false;
        int wgid = (int)L; { const int q = nwg / NXCD, r = nwg % NXCD, xcd = wgid % NXCD, off = wgid / NXCD; wgid = (xcd < r ? xcd * (q + 1) : r * (q + 1) + (xcd - r) * q) + off; }
        const int nig = WGM * nN, gid = wgid / nig, fm = gid * WGM, gsz = (nM - fm) < WGM ? (nM - fm) : WGM;
        u.pm = fm + ((wgid % nig) % gsz); u.pn = (wgid % nig) / gsz; return true;
    }
};

template <class Epi, bool ALIGN_EPI = true, bool SP2 = true>
__device__ __forceinline__ void gemm_phase(PG8_LAS unsigned char* lds, const Gemm g, const StaticOrder& S, const Epi& E) {
    const int tid = threadIdx.x, wid = __builtin_amdgcn_readfirstlane(tid >> 6), lane = tid & 63, wr = wid >> 2, wc = wid & 3, fr = lane & 15, fq = lane >> 4;
    const int K = g.K, nt = K / BK;
    unsigned voffA[2], voffB[2];
#pragma unroll
    for (int i = 0; i < 2; ++i) { int R, C; stage_rc(tid * 16 + i * 8192, R, C); const int Rb = Epi::PERM ? ((R & ~31) + perm32(R & 31)) : R;
        voffA[i] = (unsigned)(R * K + C) * 2u; voffB[i] = (unsigned)(Rb * K + C) * 2u; }
    const size_t kstep = (size_t)(BK * 2);
    const size_t hstep = (size_t)HALF * K * 2;
    const size_t tstep = 2 * hstep;
    const unsigned ldsw = (unsigned)wid * 1024u;
    const int aoff = lds_byte(wr * 64 + fr, fq * 8), boff = lds_byte(wc * 32 + fr, fq * 8);
#define PG8_SA(b, h) (((b) * 2 + (h)) * HTB)
#define PG8_SB(b, h) ((4 + (b) * 2 + (h)) * HTB)
#define PG8_STAGE(bufoff, gbase, voff) do { _Pragma("unroll") for (int _i = 0; _i < 2; ++_i) \
        __builtin_amdgcn_global_load_lds((const unsigned*)((const char*)(gbase) + (voff)[_i]), (PG8_LAS unsigned*)(lds + (bufoff) + ldsw + _i * 8192), 16, 0, 0); } while (0)
#define PG8_LDA(dst, b, h) do { _Pragma("unroll") for (int m = 0; m < 4; ++m) _Pragma("unroll") for (int k = 0; k < 2; ++k) dst[m][k] = *(const PG8_LAS bf16x8*)(lds + PG8_SA(b, h) + aoff + m * 2048 + k * 1024); } while (0)
#define PG8_LDB(dst, b, h) do { _Pragma("unroll") for (int n = 0; n < 2; ++n) _Pragma("unroll") for (int k = 0; k < 2; ++k) dst[n][k] = *(const PG8_LAS bf16x8*)(lds + PG8_SB(b, h) + boff + n * 2048 + k * 1024); } while (0)
#define PG8_MMA(ai, bj, At, Bt) do { __builtin_amdgcn_s_setprio(1); _Pragma("unroll") for (int m = 0; m < 4; ++m) _Pragma("unroll") for (int n = 0; n < 2; ++n) _Pragma("unroll") for (int k = 0; k < 2; ++k) \
        acc[ai][bj][m][n] = __builtin_amdgcn_mfma_f32_16x16x32_bf16(Bt[n][k], At[m][k], acc[ai][bj][m][n], 0, 0, 0); __builtin_amdgcn_s_setprio(0); } while (0)
#define PG8_WAIT_V(n) asm volatile("s_waitcnt vmcnt(" #n ")" ::: "memory")
#define PG8_WAIT_L(n) asm volatile("s_waitcnt lgkmcnt(" #n ")" ::: "memory")
#define PG8_BAR __builtin_amdgcn_s_barrier()
#define PG8_SCHED __builtin_amdgcn_sched_barrier(0)
    Unit cur, nxt; int ui = 0;
    if (!S.next(0, cur)) return;
    f32x4 acc[2][2][4][2];
#pragma unroll
    for (int a = 0; a < 2; ++a)
#pragma unroll
        for (int b = 0; b < 2; ++b)
#pragma unroll
            for (int m = 0; m < 4; ++m)
#pragma unroll
                for (int n = 0; n < 2; ++n) acc[a][b][m][n] = (f32x4){0.f, 0.f, 0.f, 0.f};
    bf16x8 At[4][2], B0[2][2], B1[2][2];
    const char* cA = (const char*)g.A + (size_t)cur.pm * tstep; const char* cB = (const char*)g.Bt + (size_t)cur.pn * tstep;
    if constexpr (SP2) {
        PG8_STAGE(PG8_SB(0, 0), cB, voffB); PG8_STAGE(PG8_SB(0, 1), cB + hstep, voffB); PG8_STAGE(PG8_SA(0, 0), cA, voffA); PG8_STAGE(PG8_SA(0, 1), cA + hstep, voffA);
        if (wr == 1) PG8_BAR;
        PG8_WAIT_V(2); PG8_BAR;
        PG8_STAGE(PG8_SB(1, 0), cB + kstep, voffB); PG8_STAGE(PG8_SA(1, 0), cA + kstep, voffA); PG8_STAGE(PG8_SB(1, 1), cB + hstep + kstep, voffB);
        PG8_WAIT_V(6); PG8_BAR;
    } else {
    PG8_STAGE(PG8_SB(0, 0), cB, voffB); PG8_STAGE(PG8_SA(0, 0), cA, voffA); PG8_STAGE(PG8_SB(0, 1), cB + hstep, voffB); PG8_STAGE(PG8_SA(0, 1), cA + hstep, voffA);
    if (wr == 1) PG8_BAR;
    PG8_WAIT_V(4); PG8_BAR;
    PG8_STAGE(PG8_SB(1, 0), cB + kstep, voffB); PG8_STAGE(PG8_SA(1, 0), cA + kstep, voffA); PG8_STAGE(PG8_SB(1, 1), cB + hstep + kstep, voffB);
    PG8_WAIT_V(6); PG8_BAR;
    }
    for (;;) {
        const bool has_next = S.next(ui + 1, nxt);
        const char* nA = has_next ? (const char*)g.A + (size_t)nxt.pm * tstep : cA; const char* nB = has_next ? (const char*)g.Bt + (size_t)nxt.pn * tstep : cB;
        for (int t = 0; t < nt; t += 2) {
            const bool last = (t == nt - 2);
            const char* a1 = cA + (size_t)(t + 1) * kstep;
            const char* a2 = last ? nA : cA + (size_t)(t + 2) * kstep; const char* b2 = last ? nB : cB + (size_t)(t + 2) * kstep;
            const char* a3 = a2 + kstep; const char* b3 = b2 + kstep;
            if constexpr (SP2) {
            PG8_LDB(B0, 0, 0); PG8_LDB(B1, 0, 1); PG8_SCHED; PG8_LDA(At, 0, 0); PG8_STAGE(PG8_SA(1, 1), a1 + hstep, voffA);
            PG8_WAIT_V(8); PG8_WAIT_L(0); PG8_BAR; PG8_MMA(0, 0, At, B0); PG8_MMA(0, 1, At, B1); PG8_BAR; PG8_SCHED;
            PG8_LDA(At, 0, 1); PG8_STAGE(PG8_SB(0, 0), b2, voffB); PG8_STAGE(PG8_SB(0, 1), b2 + hstep, voffB); PG8_STAGE(PG8_SA(0, 0), a2, voffA);
            PG8_WAIT_V(8); PG8_WAIT_L(0); PG8_BAR; PG8_MMA(1, 0, At, B0); PG8_MMA(1, 1, At, B1); PG8_BAR; PG8_SCHED;
            PG8_LDB(B0, 1, 0); PG8_LDB(B1, 1, 1); PG8_SCHED; PG8_LDA(At, 1, 0); PG8_STAGE(PG8_SA(0, 1), a2 + hstep, voffA);
            PG8_WAIT_V(8); PG8_WAIT_L(0); PG8_BAR; PG8_MMA(0, 0, At, B0); PG8_MMA(0, 1, At, B1); PG8_BAR; PG8_SCHED;
            PG8_LDA(At, 1, 1); PG8_STAGE(PG8_SB(1, 0), b3, voffB); PG8_STAGE(PG8_SB(1, 1), b3 + hstep, voffB); PG8_STAGE(PG8_SA(1, 0), a3, voffA);
            PG8_WAIT_V(8); PG8_WAIT_L(0); PG8_BAR; PG8_MMA(1, 0, At, B0); PG8_MMA(1, 1, At, B1); PG8_BAR; PG8_SCHED;
            } else {
            PG8_LDB(B0, 0, 0); PG8_SCHED; PG8_LDA(At, 0, 0); PG8_STAGE(PG8_SA(1, 1), a1 + hstep, voffA);
            PG8_WAIT_L(8); PG8_BAR; PG8_WAIT_L(0); PG8_MMA(0, 0, At, B0); PG8_BAR; PG8_SCHED;
            PG8_LDB(B1, 0, 1); PG8_STAGE(PG8_SB(0, 0), b2, voffB);
            PG8_BAR; PG8_WAIT_L(0); PG8_MMA(0, 1, At, B1); PG8_BAR;
            PG8_LDA(At, 0, 1); PG8_STAGE(PG8_SA(0, 0), a2, voffA);
            PG8_BAR; PG8_WAIT_L(0); PG8_MMA(1, 0, At, B0); PG8_BAR; PG8_SCHED;
            PG8_STAGE(PG8_SB(0, 1), b2 + hstep, voffB);
            PG8_WAIT_V(6); PG8_BAR; PG8_MMA(1, 1, At, B1); PG8_BAR;
            PG8_LDB(B0, 1, 0); PG8_SCHED; PG8_LDA(At, 1, 0); PG8_STAGE(PG8_SA(0, 1), a2 + hstep, voffA);
            PG8_WAIT_L(8); PG8_BAR; PG8_WAIT_L(0); PG8_MMA(0, 0, At, B0); PG8_BAR; PG8_SCHED;
            PG8_LDB(B1, 1, 1); PG8_STAGE(PG8_SB(1, 0), b3, voffB);
            PG8_BAR; PG8_WAIT_L(0); PG8_MMA(0, 1, At, B1); PG8_BAR;
            PG8_LDA(At, 1, 1); PG8_STAGE(PG8_SA(1, 0), a3, voffA);
            PG8_BAR; PG8_WAIT_L(0); PG8_MMA(1, 0, At, B0); PG8_BAR; PG8_SCHED;
            PG8_STAGE(PG8_SB(1, 1), b3 + hstep, voffB);
            PG8_WAIT_V(6); PG8_BAR; PG8_MMA(1, 1, At, B1); PG8_BAR;
            }
        }
        if constexpr (ALIGN_EPI) { if (wr == 0) PG8_BAR; }
        E(acc, cur, wr, wc, fr, fq);
        if (!has_next) break;
#pragma unroll
        for (int a = 0; a < 2; ++a)
#pragma unroll
            for (int b = 0; b < 2; ++b)
#pragma unroll
                for (int m = 0; m < 4; ++m)
#pragma unroll
                    for (int n = 0; n < 2; ++n) acc[a][b][m][n] = (f32x4){0.f, 0.f, 0.f, 0.f};
        cur = nxt; cA = nA; cB = nB; ++ui;
        if constexpr (ALIGN_EPI) { if (wr == 1) PG8_BAR; }
    }
    PG8_WAIT_V(0);
    if constexpr (!ALIGN_EPI) { if (wr == 0) PG8_BAR; }
    PG8_BAR;
#undef PG8_SA
#undef PG8_SB
#undef PG8_STAGE
#undef PG8_LDA
#undef PG8_LDB
#undef PG8_MMA
#undef PG8_WAIT_V
#undef PG8_WAIT_L
#undef PG8_BAR
#undef PG8_SCHED
}
}

struct EpiPlain {
    static constexpr bool PERM = true;
    bf16_t* O; int ldc;
    DI void operator()(const f32x4 (&acc)[2][2][4][2], const pg8::Unit& u, int wr, int wc, int fr, int fq) const {
        const int row0 = u.pm * 256 + wr * 64 + fr, col0 = u.pn * 256 + wc * 32 + 8 * fq;
#pragma unroll
        for (int ai = 0; ai < 2; ++ai)
#pragma unroll
            for (int m = 0; m < 4; ++m) { bf16_t* rowp = O + (size_t)(row0 + ai * 128 + m * 16) * ldc + col0;
#pragma unroll
                for (int bj = 0; bj < 2; ++bj) { const f32x4 v0 = acc[ai][bj][m][0], v1 = acc[ai][bj][m][1];
                    u32x4 w; w.x = cvt_pk_bf16(v0[0], v0[1]); w.y = cvt_pk_bf16(v0[2], v0[3]); w.z = cvt_pk_bf16(v1[0], v1[1]); w.w = cvt_pk_bf16(v1[2], v1[3]);
                    *(u32x4*)(rowp + bj * 128) = w; } }
    }
};
struct EpiRelu2 {
    static constexpr bool PERM = true;
    bf16_t* O; int ldc;
    DI void operator()(const f32x4 (&acc)[2][2][4][2], const pg8::Unit& u, int wr, int wc, int fr, int fq) const {
        const int row0 = u.pm * 256 + wr * 64 + fr, col0 = u.pn * 256 + wc * 32 + 8 * fq;
#pragma unroll
        for (int ai = 0; ai < 2; ++ai)
#pragma unroll
            for (int m = 0; m < 4; ++m) { bf16_t* rowp = O + (size_t)(row0 + ai * 128 + m * 16) * ldc + col0;
#pragma unroll
                for (int bj = 0; bj < 2; ++bj) { f32x4 v0 = acc[ai][bj][m][0], v1 = acc[ai][bj][m][1];
#pragma unroll
                    for (int j = 0; j < 4; ++j) { const float a = fmaxf(v0[j], 0.f), b = fmaxf(v1[j], 0.f); v0[j] = a * a; v1[j] = b * b; }
                    u32x4 w; w.x = cvt_pk_bf16(v0[0], v0[1]); w.y = cvt_pk_bf16(v0[2], v0[3]); w.z = cvt_pk_bf16(v1[0], v1[1]); w.w = cvt_pk_bf16(v1[2], v1[3]);
                    *(u32x4*)(rowp + bj * 128) = w; } }
    }
};
struct EpiRes {
    static constexpr bool PERM = true;
    bf16_t* O; const bf16_t* R;
    DI void operator()(const f32x4 (&acc)[2][2][4][2], const pg8::Unit& u, int wr, int wc, int fr, int fq) const {
        const int row0 = u.pm * 256 + wr * 64 + fr, col0 = u.pn * 256 + wc * 32 + 8 * fq;
#pragma unroll
        for (int ai = 0; ai < 2; ++ai)
#pragma unroll
            for (int m = 0; m < 4; ++m) { const size_t off = (size_t)(row0 + ai * 128 + m * 16) * 1024 + col0;
#pragma unroll
                for (int bj = 0; bj < 2; ++bj) { const f32x4 v0 = acc[ai][bj][m][0], v1 = acc[ai][bj][m][1];
                    const u32x4 rr = *(const u32x4*)(R + off + bj * 128);
                    u32x4 w;
                    w.x = cvt_pk_bf16(ALPHA_C * bf_lo(rr.x) + v0[0], ALPHA_C * bf_hi(rr.x) + v0[1]); w.y = cvt_pk_bf16(ALPHA_C * bf_lo(rr.y) + v0[2], ALPHA_C * bf_hi(rr.y) + v0[3]);
                    w.z = cvt_pk_bf16(ALPHA_C * bf_lo(rr.z) + v1[0], ALPHA_C * bf_hi(rr.z) + v1[1]); w.w = cvt_pk_bf16(ALPHA_C * bf_lo(rr.w) + v1[2], ALPHA_C * bf_hi(rr.w) + v1[3]);
                    *(u32x4*)(O + off + bj * 128) = w; } }
    }
};
struct EpiQKV {
    static constexpr bool PERM = true;
    bf16_t* O; const float* rc; const float* rs;
    DI void operator()(const f32x4 (&acc)[2][2][4][2], const pg8::Unit& u, int wr, int wc, int fr, int fq) const {
        const int row0 = u.pm * 256 + wr * 64 + fr, col0 = u.pn * 256 + wc * 32 + 8 * fq;
        const bool rot = u.pn < 4; const int i0 = 16 * (wc & 1) + 4 * fq;
#pragma unroll
        for (int ai = 0; ai < 2; ++ai)
#pragma unroll
            for (int m = 0; m < 4; ++m) { const int row = row0 + ai * 128 + m * 16; bf16_t* rowp = O + (size_t)row * 3072 + col0;
                f32x4 c4 = (f32x4){1.f, 1.f, 1.f, 1.f}, s4 = (f32x4){0.f, 0.f, 0.f, 0.f};
                if (rot) { const int t = row & (row < MP ? 4095 : 8191); c4 = *(const f32x4*)(rc + t * 32 + i0); s4 = *(const f32x4*)(rs + t * 32 + i0); }
#pragma unroll
                for (int bj = 0; bj < 2; ++bj) { const f32x4 v0 = acc[ai][bj][m][0], v1 = acc[ai][bj][m][1];
                    const f32x4 o0 = v0 * c4 - v1 * s4, o1 = v1 * c4 + v0 * s4;
                    u32x4 w; w.x = cvt_pk_bf16(o0[0], o0[1]); w.y = cvt_pk_bf16(o0[2], o0[3]); w.z = cvt_pk_bf16(o1[0], o1[1]); w.w = cvt_pk_bf16(o1[2], o1[3]);
                    *(u32x4*)(rowp + bj * 128) = w; }
                if (m == 3) asm volatile("" ::: "memory"); }
    }
};

DI void wave_sum2(float& a, float& b) { for (int o = 32; o >= 1; o >>= 1) { a += __shfl_xor(a, o); b += __shfl_xor(b, o); } }
DI void wave_sum4(float& a, float& b, float& c, float& d) { for (int o = 32; o >= 1; o >>= 1) { a += __shfl_xor(a, o); b += __shfl_xor(b, o); c += __shfl_xor(c, o); d += __shfl_xor(d, o); } }
template <bool OUTF32>
DI void ln_store(f32x4 v0, f32x4 v1, f32x4 v2, f32x4 v3, float mean, float rstd, const f32x4 (&g)[4], const f32x4 (&b)[4], bf16_t* __restrict__ X, float* __restrict__ OF, int row, int lane) {
    v0 = (v0 - mean) * rstd * g[0] + b[0]; v1 = (v1 - mean) * rstd * g[1] + b[1]; v2 = (v2 - mean) * rstd * g[2] + b[2]; v3 = (v3 - mean) * rstd * g[3] + b[3];
    if (OUTF32) { float* o = OF + (size_t)row * 1024; *(f32x4*)(o + lane * 8) = v0; *(f32x4*)(o + lane * 8 + 4) = v1; *(f32x4*)(o + 512 + lane * 8) = v2; *(f32x4*)(o + 516 + lane * 8) = v3; }
    else { u32x4 w; w.x = cvt_pk_bf16(v0[0], v0[1]); w.y = cvt_pk_bf16(v0[2], v0[3]); w.z = cvt_pk_bf16(v1[0], v1[1]); w.w = cvt_pk_bf16(v1[2], v1[3]);
        *(u32x4*)(X + (size_t)row * 1024 + lane * 8) = w;
        w.x = cvt_pk_bf16(v2[0], v2[1]); w.y = cvt_pk_bf16(v2[2], v2[3]); w.z = cvt_pk_bf16(v3[0], v3[1]); w.w = cvt_pk_bf16(v3[2], v3[3]);
        *(u32x4*)(X + (size_t)row * 1024 + 512 + lane * 8) = w; }
}
DI float hsum(const f32x4& t) { return (t[0] + t[1]) + (t[2] + t[3]); }
DI void transpose_w(const float* __restrict__ W, int K, int N, bf16_t* __restrict__ Wt, int mode, const float* ga, const float* gb, int gw, int nw, int lane) {
    const int nNb = N >> 6, units = nNb * (K >> 6);
    for (int u = gw; u < units; u += nw) {
        const int nb = u % nNb, kb = u / nNb, n = nb * 64 + lane; int src = n; float sc = 1.f;
        if (mode == 1) { if (n < 1024) { const int hd = n >> 6, p = n & 63, j = p >> 3, e = p & 7; src = (hd << 6) + (e < 4 ? 4 * j + e : 32 + 4 * j + (e - 4)); }
            if (n < 512 || (n >= 1536 && n < 2048)) sc = 0.125f; }
        if (mode == 3) sc = 0.0625f;
#pragma unroll
        for (int kk = 0; kk < 8; ++kk) { const int k0 = kb * 64 + kk * 8; float v[8];
#pragma unroll
            for (int j = 0; j < 8; ++j) { float x = W[(size_t)(k0 + j) * N + src] * sc; if (mode == 2) x *= (k0 + j < 512) ? ga[k0 + j] : gb[k0 + j - 512]; v[j] = x; }
            u32x4 w; w.x = cvt_pk_bf16(v[0], v[1]); w.y = cvt_pk_bf16(v[2], v[3]); w.z = cvt_pk_bf16(v[4], v[5]); w.w = cvt_pk_bf16(v[6], v[7]);
            *(u32x4*)(Wt + (size_t)n * K + k0) = w; }
    }
}
DI void phase_prologue(const Params& p, int gw, int nw, int lane) {
    unsigned char* sm = p.out;
    transpose_w(p.w_in, 1024, 3072, (bf16_t*)(sm + SM_WIN), 1, nullptr, nullptr, gw, nw, lane);
    transpose_w(p.w_out, 1024, 1024, (bf16_t*)(sm + SM_WOUT), 2, p.g_mix_a, p.g_mix_b, gw, nw, lane);
    transpose_w(p.w_xq, 1024, 1024, (bf16_t*)(sm + SM_WXQ), 3, nullptr, nullptr, gw, nw, lane);
    transpose_w(p.w_xkv, 1024, 2048, (bf16_t*)(sm + SM_WXKV), 0, nullptr, nullptr, gw, nw, lane);
    transpose_w(p.w_xo, 1024, 1024, (bf16_t*)(sm + SM_WXO), 0, nullptr, nullptr, gw, nw, lane);
    transpose_w(p.w_up, 1024, 4096, (bf16_t*)(sm + SM_WUP), 0, nullptr, nullptr, gw, nw, lane);
    transpose_w(p.w_down, 4096, 1024, (bf16_t*)(sm + SM_WDOWN), 0, nullptr, nullptr, gw, nw, lane);
    { float* ss = (float*)(sm + SM_SMALL); const int gt0 = gw * 64 + lane, nt0 = nw * 64;
      for (int i = gt0; i < SS_TOTAL; i += nt0) { float v = 0.f;
          if (i < 3720) v = p.rpb[i]; else if (i >= SS_LN1G && i < SS_LN1G + 1024) v = p.ln1_g[i - SS_LN1G]; else if (i >= SS_LN1B && i < SS_LN1B + 1024) v = p.ln1_b[i - SS_LN1B];
          else if (i >= SS_LN2G && i < SS_LN2G + 1024) v = p.ln2_g[i - SS_LN2G]; else if (i >= SS_LN2B && i < SS_LN2B + 1024) v = p.ln2_b[i - SS_LN2B];
          ss[i] = v; } }
    { bf16_t* mb = (bf16_t*)(sm + SM_MEMB); const int gt = gw * 64 + lane, nt = nw * 64;
      for (int i = gt; i < NMEM * 1024 / 8; i += nt) { const int e = i * 8; const float* s = e < 4096 * 1024 ? p.mem_prompt + e : p.mem_sample + (e - 4096 * 1024);
          const f32x4 a = *(const f32x4*)s, b = *(const f32x4*)(s + 4); u32x4 w; w.x = cvt_pk_bf16(a[0], a[1]); w.y = cvt_pk_bf16(a[2], a[3]); w.z = cvt_pk_bf16(b[0], b[1]); w.w = cvt_pk_bf16(b[2], b[3]);
          *(u32x4*)(mb + e) = w; }
      float* rc = (float*)(sm + SM_RC); float* rs = (float*)(sm + SM_RS);
      for (int i = gt; i < 8192 * 32; i += nt) { const int t = i >> 5, f = i & 31; const float inv = powf(10000.0f, -(float)f / 32.0f); const float ang = (float)t * inv;
          const double a = (double)ang; const double kq = rint(a * 0.15915494309189535); const float r = (float)(a - kq * 6.283185307179586);
          rc[i] = cosf(r); rs[i] = sinf(r); } }
    bf16_t* XN = (bf16_t*)(p.ws + WS_XN);
    f32x4 g[4], b[4];
    g[0] = *(const f32x4*)(p.ln_in_g + lane * 8); g[1] = *(const f32x4*)(p.ln_in_g + lane * 8 + 4); g[2] = *(const f32x4*)(p.ln_in_g + 512 + lane * 8); g[3] = *(const f32x4*)(p.ln_in_g + 516 + lane * 8);
    b[0] = *(const f32x4*)(p.ln_in_b + lane * 8); b[1] = *(const f32x4*)(p.ln_in_b + lane * 8 + 4); b[2] = *(const f32x4*)(p.ln_in_b + 512 + lane * 8); b[3] = *(const f32x4*)(p.ln_in_b + 516 + lane * 8);
#pragma unroll 1
    for (int row = gw; row < MTOK; row += 2 * nw) {
        const int row2 = row + nw;
        const float* x = row < MP ? p.x_prompt + (size_t)row * 1024 : p.x_sample + (size_t)(row - MP) * 1024;
        const float* y = row2 < MP ? p.x_prompt + (size_t)row2 * 1024 : p.x_sample + (size_t)(row2 - MP) * 1024;
        const f32x4 v0 = *(const f32x4*)(x + lane * 8), v1 = *(const f32x4*)(x + lane * 8 + 4), v2 = *(const f32x4*)(x + 512 + lane * 8), v3 = *(const f32x4*)(x + 516 + lane * 8);
        const f32x4 u0 = *(const f32x4*)(y + lane * 8), u1 = *(const f32x4*)(y + lane * 8 + 4), u2 = *(const f32x4*)(y + 512 + lane * 8), u3 = *(const f32x4*)(y + 516 + lane * 8);
        float s1 = hsum((v0 + v1) + (v2 + v3)), q1 = hsum((v0 * v0 + v1 * v1) + (v2 * v2 + v3 * v3)), s2 = hsum((u0 + u1) + (u2 + u3)), q2 = hsum((u0 * u0 + u1 * u1) + (u2 * u2 + u3 * u3));
        wave_sum4(s1, q1, s2, q2);
        const float m1 = s1 * (1.f / 1024.f), m2 = s2 * (1.f / 1024.f);
        const float r1 = rsqrtf(fmaxf(q1 * (1.f / 1024.f) - m1 * m1, 0.f) + LN_EPS_C), r2 = rsqrtf(fmaxf(q2 * (1.f / 1024.f) - m2 * m2, 0.f) + LN_EPS_C);
        ln_store<false>(v0, v1, v2, v3, m1, r1, g, b, XN, nullptr, row, lane);
        ln_store<false>(u0, u1, u2, u3, m2, r2, g, b, XN, nullptr, row2, lane);
    }
}

template <bool OUTF32>
DI void phase_ln(const bf16_t* __restrict__ Z, const float* __restrict__ gam, const float* __restrict__ bet, bf16_t* __restrict__ X, float* __restrict__ OF, int gw, int nw, int lane) {
    f32x4 g[4], b[4];
    g[0] = *(const f32x4*)(gam + lane * 8); g[1] = *(const f32x4*)(gam + lane * 8 + 4); g[2] = *(const f32x4*)(gam + 512 + lane * 8); g[3] = *(const f32x4*)(gam + 516 + lane * 8);
    b[0] = *(const f32x4*)(bet + lane * 8); b[1] = *(const f32x4*)(bet + lane * 8 + 4); b[2] = *(const f32x4*)(bet + 512 + lane * 8); b[3] = *(const f32x4*)(bet + 516 + lane * 8);
#pragma unroll 1
    for (int row = gw; row < MTOK; row += 2 * nw) {
        const int row2 = row + nw;
        const u32x4 za = *(const u32x4*)(Z + (size_t)row * 1024 + lane * 8), zb = *(const u32x4*)(Z + (size_t)row * 1024 + 512 + lane * 8);
        const u32x4 zc = *(const u32x4*)(Z + (size_t)row2 * 1024 + lane * 8), zd = *(const u32x4*)(Z + (size_t)row2 * 1024 + 512 + lane * 8);
        const f32x4 v0 = (f32x4){bf_lo(za.x), bf_hi(za.x), bf_lo(za.y), bf_hi(za.y)}, v1 = (f32x4){bf_lo(za.z), bf_hi(za.z), bf_lo(za.w), bf_hi(za.w)};
        const f32x4 v2 = (f32x4){bf_lo(zb.x), bf_hi(zb.x), bf_lo(zb.y), bf_hi(zb.y)}, v3 = (f32x4){bf_lo(zb.z), bf_hi(zb.z), bf_lo(zb.w), bf_hi(zb.w)};
        const f32x4 u0 = (f32x4){bf_lo(zc.x), bf_hi(zc.x), bf_lo(zc.y), bf_hi(zc.y)}, u1 = (f32x4){bf_lo(zc.z), bf_hi(zc.z), bf_lo(zc.w), bf_hi(zc.w)};
        const f32x4 u2 = (f32x4){bf_lo(zd.x), bf_hi(zd.x), bf_lo(zd.y), bf_hi(zd.y)}, u3 = (f32x4){bf_lo(zd.z), bf_hi(zd.z), bf_lo(zd.w), bf_hi(zd.w)};
        float s1 = hsum((v0 + v1) + (v2 + v3)), q1 = hsum((v0 * v0 + v1 * v1) + (v2 * v2 + v3 * v3)), s2 = hsum((u0 + u1) + (u2 + u3)), q2 = hsum((u0 * u0 + u1 * u1) + (u2 * u2 + u3 * u3));
        wave_sum4(s1, q1, s2, q2);
        const float m1 = s1 * (1.f / 1024.f), m2 = s2 * (1.f / 1024.f);
        const float r1 = rsqrtf(fmaxf(q1 * (1.f / 1024.f) - m1 * m1, 0.f) + LN_EPS_C), r2 = rsqrtf(fmaxf(q2 * (1.f / 1024.f) - m2 * m2, 0.f) + LN_EPS_C);
        ln_store<OUTF32>(v0, v1, v2, v3, m1, r1, g, b, X, OF, row, lane);
        ln_store<OUTF32>(u0, u1, u2, u3, m2, r2, g, b, X, OF, row2, lane);
    }
}

constexpr int VROW = 144;
constexpr int VWAVE = 64 * VROW;
constexpr int LDS_RMS = 8 * VWAVE;
constexpr int LDS_RPB = LDS_RMS + 1024;

DI void tr_read8(unsigned addr, s16x4 (&r)[8]) {
    asm volatile("s_waitcnt lgkmcnt(0)\n\t"
                 "ds_read_b64_tr_b16 %0, %8 offset:0\n\t" "ds_read_b64_tr_b16 %1, %8 offset:2304\n\t"
                 "ds_read_b64_tr_b16 %2, %8 offset:32\n\t" "ds_read_b64_tr_b16 %3, %8 offset:2336\n\t"
                 "ds_read_b64_tr_b16 %4, %8 offset:64\n\t" "ds_read_b64_tr_b16 %5, %8 offset:2368\n\t"
                 "ds_read_b64_tr_b16 %6, %8 offset:96\n\t" "ds_read_b64_tr_b16 %7, %8 offset:2400\n\t"
                 "s_waitcnt lgkmcnt(0)"
                 : "=&v"(r[0]), "=&v"(r[1]), "=&v"(r[2]), "=&v"(r[3]), "=&v"(r[4]), "=&v"(r[5]), "=&v"(r[6]), "=&v"(r[7]) : "v"(addr) : "memory");
}

template <int NO>
DI void softmax_chunk(f32x4 (&s)[4], float& m, float& l, f32x4 (&o)[NO], bf16x8 (&pf)[2]) {
    float mx = fmaxf(fmaxf(fmaxf(s[0][0], s[0][1]), fmaxf(s[0][2], s[0][3])), fmaxf(fmaxf(s[1][0], s[1][1]), fmaxf(s[1][2], s[1][3])));
    mx = fmaxf(mx, fmaxf(fmaxf(fmaxf(s[2][0], s[2][1]), fmaxf(s[2][2], s[2][3])), fmaxf(fmaxf(s[3][0], s[3][1]), fmaxf(s[3][2], s[3][3]))));
    if (__builtin_amdgcn_ballot_w64(mx > m + 16.f)) {
        mx = fmaxf(mx, __shfl_xor(mx, 16)); mx = fmaxf(mx, __shfl_xor(mx, 32));
        const float mn = fmaxf(m, mx), alpha = __builtin_amdgcn_exp2f((m - mn) * LOG2E_C); m = mn; l *= alpha;
#pragma unroll
        for (int c = 0; c < NO; ++c) o[c] *= alpha;
    }
    const float nb = -m * LOG2E_C;
    float ps = 0.f;
#pragma unroll
    for (int kt = 0; kt < 4; ++kt)
#pragma unroll
        for (int e = 0; e < 4; ++e) { const float pv = __builtin_amdgcn_exp2f(s[kt][e] * LOG2E_C + nb); s[kt][e] = pv; ps += pv; }
    l += ps;
#pragma unroll
    for (int pr = 0; pr < 2; ++pr) { u32x4 w; w.x = cvt_pk_bf16(s[2 * pr][0], s[2 * pr][1]); w.y = cvt_pk_bf16(s[2 * pr][2], s[2 * pr][3]);
        w.z = cvt_pk_bf16(s[2 * pr + 1][0], s[2 * pr + 1][1]); w.w = cvt_pk_bf16(s[2 * pr + 1][2], s[2 * pr + 1][3]); pf[pr] = __builtin_bit_cast(bf16x8, w); }
}

template <int NCH, class KOff, class VOff, class Score>
DI void attn64_run(const char* __restrict__ qkvb, const bf16x8 q0, const bf16x8 q1, unsigned char* vl, int lane, f32x4 (&o)[4], float& m, float& l, KOff koff, VOff voff, Score score) {
    const int fr = lane & 15, fq = lane >> 4;
    const unsigned vaddr = (unsigned)(size_t)vl + (unsigned)((4 * fq + (fr >> 2)) * VROW + (fr & 3) * 8);
    unsigned char* vw = vl + (lane >> 3) * VROW + (lane & 7) * 16;
    const unsigned char* krd = vl + fr * VROW + fq * 16;
    u32x4 kr[8], vr[8];
#pragma unroll
    for (int it = 0; it < 8; ++it) kr[it] = *(const u32x4*)(qkvb + koff(0, it));
#pragma unroll
    for (int it = 0; it < 8; ++it) vr[it] = *(const u32x4*)(qkvb + voff(0, it));
#pragma unroll 1
    for (int c = 0; c < NCH; ++c) {
        u32x4 vc[8];
#pragma unroll
        for (int it = 0; it < 8; ++it) *(u32x4*)(vw + it * 8 * VROW) = kr[it];
#pragma unroll
        for (int it = 0; it < 8; ++it) vc[it] = vr[it];
        __builtin_amdgcn_fence(__ATOMIC_RELEASE, "wavefront");
        bf16x8 kc[4][2];
#pragma unroll
        for (int kt = 0; kt < 4; ++kt) { kc[kt][0] = *(const bf16x8*)(krd + kt * 16 * VROW); kc[kt][1] = *(const bf16x8*)(krd + kt * 16 * VROW + 64); }
        if (c + 1 < NCH) {
#pragma unroll
            for (int it = 0; it < 8; ++it) kr[it] = *(const u32x4*)(qkvb + koff(c + 1, it));
#pragma unroll
            for (int it = 0; it < 8; ++it) vr[it] = *(const u32x4*)(qkvb + voff(c + 1, it));
        }
        f32x4 s[4];
#pragma unroll
        for (int kt = 0; kt < 4; ++kt) { s[kt] = __builtin_amdgcn_mfma_f32_16x16x32_bf16(kc[kt][0], q0, (f32x4){0.f, 0.f, 0.f, 0.f}, 0, 0, 0); s[kt] = __builtin_amdgcn_mfma_f32_16x16x32_bf16(kc[kt][1], q1, s[kt], 0, 0, 0); }
#pragma unroll
        for (int kt = 0; kt < 4; ++kt)
#pragma unroll
            for (int e = 0; e < 4; ++e) s[kt][e] = score(c, s[kt][e], kt, e);
        bf16x8 pf[2];
        softmax_chunk<4>(s, m, l, o, pf);
#pragma unroll
        for (int it = 0; it < 8; ++it) *(u32x4*)(vw + it * 8 * VROW) = vc[it];
#pragma unroll
        for (int pr = 0; pr < 2; ++pr) { s16x4 t[8]; tr_read8(vaddr + pr * 32 * VROW, t);
#pragma unroll
            for (int dc = 0; dc < 4; ++dc) { const bf16x8 vf = __builtin_shufflevector(t[2 * dc], t[2 * dc + 1], 0, 1, 2, 3, 4, 5, 6, 7); o[dc] = __builtin_amdgcn_mfma_f32_16x16x32_bf16(vf, pf[pr], o[dc], 0, 0, 0); } }
    }
}

template <int NO>
DI void softmax_pair(f32x4& s0, f32x4& s1, float& m, float& l, f32x4 (&o)[NO], bf16x8& pf) {
    float mx = fmaxf(fmaxf(fmaxf(s0[0], s0[1]), fmaxf(s0[2], s0[3])), fmaxf(fmaxf(s1[0], s1[1]), fmaxf(s1[2], s1[3])));
    if (__builtin_amdgcn_ballot_w64(mx > m + 16.f)) {
        mx = fmaxf(mx, __shfl_xor(mx, 16)); mx = fmaxf(mx, __shfl_xor(mx, 32));
        const float mn = fmaxf(m, mx), alpha = __builtin_amdgcn_exp2f((m - mn) * LOG2E_C); m = mn; l *= alpha;
#pragma unroll
        for (int c = 0; c < NO; ++c) o[c] *= alpha;
    }
    const float nb = -m * LOG2E_C;
    float ps = 0.f;
#pragma unroll
    for (int e = 0; e < 4; ++e) { s0[e] = __builtin_amdgcn_exp2f(s0[e] * LOG2E_C + nb); s1[e] = __builtin_amdgcn_exp2f(s1[e] * LOG2E_C + nb); ps += s0[e] + s1[e]; }
    l += ps;
    u32x4 w; w.x = cvt_pk_bf16(s0[0], s0[1]); w.y = cvt_pk_bf16(s0[2], s0[3]); w.z = cvt_pk_bf16(s1[0], s1[1]); w.w = cvt_pk_bf16(s1[2], s1[3]); pf = __builtin_bit_cast(bf16x8, w);
}
template <int NG, class KOff, class VOff, class Score, class Use, class Full>
DI void attn_mg_run(const int nimg, const char* __restrict__ qkvb, unsigned char* vl, int lane, f32x4 (&o)[NG][4], float (&m)[NG], float (&l)[NG], const bf16x8 (&q0)[NG], const bf16x8 (&q1)[NG],
                    KOff koff, VOff voff, Score score, Use use, Full full) {
    const int fr = lane & 15, fq = lane >> 4;
    const unsigned vaddr = (unsigned)(size_t)vl + (unsigned)(32 * VROW + (4 * fq + (fr >> 2)) * VROW + (fr & 3) * 8);
    unsigned char* vw = vl + (lane >> 3) * VROW + (lane & 7) * 16;
    const unsigned char* krd = vl + fr * VROW + fq * 16;
    u32x4 kr[4], vr[4];
#pragma unroll
    for (int j = 0; j < 4; ++j) { kr[j] = *(const u32x4*)(qkvb + koff(0, j)); vr[j] = *(const u32x4*)(qkvb + voff(0, j)); }
#pragma unroll 1
    for (int i = 0; i < nimg; ++i) {
#pragma unroll
        for (int j = 0; j < 4; ++j) { *(u32x4*)(vw + j * 8 * VROW) = kr[j]; *(u32x4*)(vw + (32 + j * 8) * VROW) = vr[j]; }
        __builtin_amdgcn_fence(__ATOMIC_RELEASE, "wavefront");
        bf16x8 kc[2][2];
#pragma unroll
        for (int kt = 0; kt < 2; ++kt) { kc[kt][0] = *(const bf16x8*)(krd + kt * 16 * VROW); kc[kt][1] = *(const bf16x8*)(krd + kt * 16 * VROW + 64); }
        if (i + 1 < nimg) {
#pragma unroll
            for (int j = 0; j < 4; ++j) { kr[j] = *(const u32x4*)(qkvb + koff(i + 1, j)); vr[j] = *(const u32x4*)(qkvb + voff(i + 1, j)); }
        }
        bf16x8 pf[NG];
#pragma unroll
        for (int g = 0; g < NG; ++g) {
            if (use(i, g)) {
                f32x4 s0 = __builtin_amdgcn_mfma_f32_16x16x32_bf16(kc[0][0], q0[g], (f32x4){0.f, 0.f, 0.f, 0.f}, 0, 0, 0); s0 = __builtin_amdgcn_mfma_f32_16x16x32_bf16(kc[0][1], q1[g], s0, 0, 0, 0);
                f32x4 s1 = __builtin_amdgcn_mfma_f32_16x16x32_bf16(kc[1][0], q0[g], (f32x4){0.f, 0.f, 0.f, 0.f}, 0, 0, 0); s1 = __builtin_amdgcn_mfma_f32_16x16x32_bf16(kc[1][1], q1[g], s1, 0, 0, 0);
                if (!full(i, g)) {
#pragma unroll
                    for (int e = 0; e < 4; ++e) { s0[e] = score(i, g, s0[e], 0, e); s1[e] = score(i, g, s1[e], 1, e); } }
                softmax_pair<4>(s0, s1, m[g], l[g], o[g], pf[g]);
            }
        }
        s16x4 t[8]; tr_read8(vaddr, t);
        bf16x8 vf[4];
#pragma unroll
        for (int dc = 0; dc < 4; ++dc) vf[dc] = __builtin_shufflevector(t[2 * dc], t[2 * dc + 1], 0, 1, 2, 3, 4, 5, 6, 7);
#pragma unroll
        for (int g = 0; g < NG; ++g) {
            if (use(i, g)) {
#pragma unroll
                for (int dc = 0; dc < 4; ++dc) o[g][dc] = __builtin_amdgcn_mfma_f32_16x16x32_bf16(vf[dc], pf[g], o[g][dc], 0, 0, 0);
            }
        }
    }
}

DI void attn64_finish(f32x4 (&o)[4], float l, float* rms, int& par, int wid, int lane, bf16_t* __restrict__ dst  ) {
    const int fr = lane & 15, fq = lane >> 4;
    l += __shfl_xor(l, 16); l += __shfl_xor(l, 32);
    const float inv = 1.0f / l; float ss = 0.f;
#pragma unroll
    for (int c = 0; c < 4; ++c) { o[c] *= inv; ss += (o[c][0] * o[c][0] + o[c][1] * o[c][1]) + (o[c][2] * o[c][2] + o[c][3] * o[c][3]); }
    ss += __shfl_xor(ss, 16); ss += __shfl_xor(ss, 32);
    float* rb = rms + par * 128;
    if (fq == 0) rb[wid * 16 + fr] = ss;
    __syncthreads();
    float tot = 0.f;
#pragma unroll
    for (int w = 0; w < 8; ++w) tot += rb[w * 16 + fr];
    const float rstd = rsqrtf(tot * (1.f / 512.f) + LN_EPS_C);
#pragma unroll
    for (int c = 0; c < 4; ++c) { u32x2 w; w.x = cvt_pk_bf16(o[c][0] * rstd, o[c][1] * rstd); w.y = cvt_pk_bf16(o[c][2] * rstd, o[c][3] * rstd); *(u32x2*)(dst + 16 * c + 4 * fq) = w; }
    par ^= 1;
}

DI void phase_attn(const Params& p, unsigned char* shm, int wid, int lane, int vcu) {
    const bf16_t* QKV = (const bf16_t*)(p.ws + WS_QKV); bf16_t* O = (bf16_t*)(p.out + OUT_O); const char* qkvb = (const char*)QKV;
    const int fr = lane & 15, fq = lane >> 4, h = wid, l3 = lane >> 3, l7 = lane & 7;
    unsigned char* vl = shm + wid * VWAVE; float* rms = (float*)(shm + LDS_RMS); float* rpbs = (float*)(shm + LDS_RPB);
    for (int i = threadIdx.x; i < 8 * 465 + 192; i += 512) rpbs[i] = (i >= 96 && i < 96 + 8 * 465) ? ((const float*)(p.out + SM_SMALL))[SS_RPB + i - 96] : 0.f;
    __syncthreads();
    int par = 0;
    float* ML = (float*)(p.out + SM_ML);
    for (int item = vcu; item < MTOK / 256; item += gridDim.x) {
        const int row_base = item * 256; const int T_ = row_base < MP ? 4096 : 8192; const int bb_ = row_base < MP ? (row_base & ~4095) : MP + ((row_base - MP) & ~8191); const int t0_ = row_base - bb_;
        const unsigned kcolb = (unsigned)(512 + h * 64) * 2u + 16u * l7, vcolb = (unsigned)(1024 + h * 64) * 2u + 16u * l7;
#pragma unroll 1
        for (int blk = 0; blk < (NO_P1 ? 0 : 4); ++blk) {
            int t0 = t0_, bb = bb_, T = T_; asm volatile("" : "+s"(t0), "+s"(bb), "+s"(T));
            const int tb = t0 + 64 * blk, kb = tb - 64;
            f32x4 o[4][4]; float m[4], l[4]; bf16x8 q0[4], q1[4];
#pragma unroll
            for (int g = 0; g < 4; ++g) { const bf16_t* qp = QKV + (size_t)(bb + tb + 16 * g + fr) * 3072 + h * 64 + 8 * fq; q0[g] = *(const bf16x8*)qp; q1[g] = *(const bf16x8*)(qp + 32); m[g] = -1e30f; l[g] = 0.f;
#pragma unroll
                for (int c = 0; c < 4; ++c) o[g][c] = (f32x4){0.f, 0.f, 0.f, 0.f}; }
            auto koff = [&](int i, int j) -> unsigned { int jj = kb + 32 * i + 8 * j + l3; jj = jj < 0 ? 0 : (jj > T - 1 ? T - 1 : jj); return (unsigned)(bb + jj) * 6144u + kcolb; };
            auto voff = [&](int i, int j) -> unsigned { int jj = kb + 32 * i + 8 * j + l3; jj = jj < 0 ? 0 : (jj > T - 1 ? T - 1 : jj); return (unsigned)(bb + jj) * 6144u + vcolb; };
            auto score = [&](int i, int g, float sv, int kt, int e) -> float { const int jq = tb + 16 * g + fr, lo = jq - 64 < 0 ? 0 : jq - 64, hi = jq + 64 > T - 1 ? T - 1 : jq + 64;
                const int base = kb + 32 * i + 4 * fq - lo; return ((unsigned)(base + 16 * kt + e) <= (unsigned)(hi - lo)) ? sv : -INFINITY; };
            auto use = [&](int i, int g) -> bool { return !((i == 5 && g < 2) || (i == 0 && g >= 2)); };
            auto full = [&](int i, int g) -> bool { return false; };
            attn_mg_run<4>(6, qkvb, vl, lane, o, m, l, q0, q1, koff, voff, score, use, full);
#pragma unroll
            for (int g = 0; g < 4; ++g) { float lt = l[g]; lt += __shfl_xor(lt, 16); lt += __shfl_xor(lt, 32);
                const size_t qrow = (size_t)(bb + tb + 16 * g + fr); const float inv = 1.0f / lt; bf16_t* dst = O + qrow * 1024 + h * 64 + 4 * fq;
#pragma unroll
                for (int c = 0; c < 4; ++c) { u32x2 w; w.x = cvt_pk_bf16(o[g][c][0] * inv, o[g][c][1] * inv); w.y = cvt_pk_bf16(o[g][c][2] * inv, o[g][c][3] * inv); *(u32x2*)(dst + 16 * c) = w; }
                if (fq == 0) { float2 ml; ml.x = m[g]; ml.y = lt; *(float2*)(ML + (qrow * 8 + h) * 2) = ml; } }
        }
    }
    __syncthreads();
    for (int item = vcu; item < MTOK / 256; item += gridDim.x) {
        const int row_base = item * 256; const int T_ = row_base < MP ? 4096 : 8192; const int bb_ = row_base < MP ? (row_base & ~4095) : MP + ((row_base - MP) & ~8191); const int t0_ = row_base - bb_;
        const unsigned kcolb = (unsigned)(512 + h * 64) * 2u + 16u * l7, vcolb = (unsigned)(1024 + h * 64) * 2u + 16u * l7;
#pragma unroll 1
        for (int r4 = 0; r4 < (NO_P2 ? 0 : 4); ++r4) { const int ah = 0;
            int t0 = t0_, bb = bb_, T = T_; asm volatile("" : "+s"(t0), "+s"(bb), "+s"(T));
            f32x4 o[4][4]; float m[4], l[4]; bf16x8 q0[4], q1[4];
#pragma unroll
            for (int a = 0; a < 4; ++a) { const size_t qrow = (size_t)(bb + t0 + r4 + 4 * (ah + a) + 16 * fr);
                const bf16_t* qp = QKV + qrow * 3072 + h * 64 + 8 * fq; q0[a] = *(const bf16x8*)qp; q1[a] = *(const bf16x8*)(qp + 32);
                const float2 ml = *(const float2*)(ML + (qrow * 8 + h) * 2); m[a] = ml.x; l[a] = fq == 0 ? ml.y : 0.f; const bf16_t* src = O + qrow * 1024 + h * 64 + 4 * fq;
#pragma unroll
                for (int c = 0; c < 4; ++c) { const u32x2 w = *(const u32x2*)(src + 16 * c); o[a][c] = (f32x4){bf_lo(w.x) * ml.y, bf_hi(w.x) * ml.y, bf_lo(w.y) * ml.y, bf_hi(w.y) * ml.y}; } }
            {
                const int L = T >> 2, kb = (t0 >> 2) - 64;
                auto koff = [&](int i, int j) -> unsigned { int jj = kb + 32 * i + 8 * j + l3; jj = jj < 0 ? 0 : (jj > L - 1 ? L - 1 : jj); return (unsigned)(bb + 4 * jj + r4) * 6144u + kcolb; };
                auto voff = [&](int i, int j) -> unsigned { int jj = kb + 32 * i + 8 * j + l3; jj = jj < 0 ? 0 : (jj > L - 1 ? L - 1 : jj); return (unsigned)(bb + 4 * jj + r4) * 6144u + vcolb; };
                auto score = [&](int i, int g, float sv, int kt, int e) -> float { const int jq = (t0 >> 2) + ah + g + 4 * fr, lo = jq - 64 < 0 ? 0 : jq - 64, hi = jq + 64 > L - 1 ? L - 1 : jq + 64;
                    const int base = kb + 32 * i + 4 * fq - lo; return ((unsigned)(base + 16 * kt + e) <= (unsigned)(hi - lo)) ? sv : -INFINITY; };
                auto use = [&](int i, int g) -> bool { return true; };
                auto full = [&](int i, int g) -> bool { return false; };
                attn_mg_run<4>(6, qkvb, vl, lane, o, m, l, q0, q1, koff, voff, score, use, full);
            }
#pragma unroll
            for (int a = 0; a < 4; ++a) {
                const int r = r4 + 4 * (ah + a), L = T >> 4, kb = (t0 >> 4) - 64;
                f32x4 (&o1)[1][4] = *reinterpret_cast<f32x4 (*)[1][4]>(&o[a]); float (&m1)[1] = *reinterpret_cast<float (*)[1]>(&m[a]); float (&l1)[1] = *reinterpret_cast<float (*)[1]>(&l[a]);
                const bf16x8 (&qa)[1] = *reinterpret_cast<const bf16x8 (*)[1]>(&q0[a]); const bf16x8 (&qb)[1] = *reinterpret_cast<const bf16x8 (*)[1]>(&q1[a]);
                auto koff = [&](int i, int j) -> unsigned { int jj = kb + 32 * i + 8 * j + l3; jj = jj < 0 ? 0 : (jj > L - 1 ? L - 1 : jj); return (unsigned)(bb + 16 * jj + r) * 6144u + kcolb; };
                auto voff = [&](int i, int j) -> unsigned { int jj = kb + 32 * i + 8 * j + l3; jj = jj < 0 ? 0 : (jj > L - 1 ? L - 1 : jj); return (unsigned)(bb + 16 * jj + r) * 6144u + vcolb; };
                auto score = [&](int i, int g, float sv, int kt, int e) -> float { const int jq = (t0 >> 4) + fr, lo = jq - 64 < 0 ? 0 : jq - 64, hi = jq + 64 > L - 1 ? L - 1 : jq + 64;
                    const int base = kb + 32 * i + 4 * fq - lo; return ((unsigned)(base + 16 * kt + e) <= (unsigned)(hi - lo)) ? sv : -INFINITY; };
                auto use = [&](int i, int g) -> bool { return true; };
                auto full = [&](int i, int g) -> bool { return false; };
                attn_mg_run<1>(5, qkvb, vl, lane, o1, m1, l1, qa, qb, koff, voff, score, use, full);
                attn64_finish(o1[0], l1[0], rms, par, wid, lane, O + (size_t)(bb + t0 + r + 16 * fr) * 1024 + h * 64);
            }
        }
    }
    for (int item = vcu; item < MTOK / 64; item += gridDim.x) {
        const int row_base = item * 64; const int T = row_base < MP ? 4096 : 8192; const int bb = row_base < MP ? (row_base & ~4095) : MP + ((row_base - MP) & ~8191);
        const int rows = T >> 6, rq = (row_base - bb) >> 6; int rs = rq - 4; rs = rs < 0 ? 0 : (rs > rows - 8 ? rows - 8 : rs);
        const unsigned kcolb = (unsigned)(2048 + h * 64) * 2u + 16u * l7, vcolb = (unsigned)(2560 + h * 64) * 2u + 16u * l7;
        f32x4 o[4][4]; float m[4], l[4]; bf16x8 q0[4], q1[4];
#pragma unroll
        for (int g = 0; g < 4; ++g) { const bf16_t* qp = QKV + (size_t)(row_base + 16 * g + fr) * 3072 + 1536 + h * 64 + 8 * fq; q0[g] = *(const bf16x8*)qp; q1[g] = *(const bf16x8*)(qp + 32); m[g] = -1e30f; l[g] = 0.f;
#pragma unroll
            for (int c = 0; c < 4; ++c) o[g][c] = (f32x4){0.f, 0.f, 0.f, 0.f}; }
        const unsigned kb0 = (unsigned)(bb + rs * 64 + l3) * 6144u;
        const float* bl = rpbs + 96 + h * 465 + 15 + (rs - rq + 7) * 31 + 4 * fq - fr;
        const int rsm = rs & 7;
        auto koff = [&](int i, int j) -> unsigned { const int a = ((i >> 1) + 8 - rsm) & 7; return kb0 + (unsigned)(a * 64 + 32 * (i & 1) + 8 * j) * 6144u + kcolb; };
        auto voff = [&](int i, int j) -> unsigned { const int a = ((i >> 1) + 8 - rsm) & 7; return kb0 + (unsigned)(a * 64 + 32 * (i & 1) + 8 * j) * 6144u + vcolb; };
        auto score = [&](int i, int g, float sv, int kt, int e) -> float { const int qc = 16 * g + fr; int cs = qc - 8; cs = cs < 0 ? 0 : (cs > 48 ? 48 : cs);
            const float bias = bl[(((i >> 1) + 8 - rsm) & 7) * 31 + 32 * (i & 1) + 16 * kt + e - 16 * g];
            return ((unsigned)(32 * (i & 1) + 4 * fq - cs + 16 * kt + e) < 16u) ? sv + bias : -INFINITY; };
        auto use = [&](int i, int g) -> bool { return (i & 1) ? (g > 0) : (g < 3); };
        auto full = [&](int i, int g) -> bool { return false; };
        attn_mg_run<4>(16, qkvb, vl, lane, o, m, l, q0, q1, koff, voff, score, use, full);
#pragma unroll
        for (int g = 0; g < 4; ++g) attn64_finish(o[g], l[g], rms, par, wid, lane, O + (size_t)(row_base + 16 * g + fr) * 1024 + 512 + h * 64);
    }
    __syncthreads();
}

constexpr int XK_PITCH = 528, XV_PITCH = 144, XK_BYTES = 64 * XK_PITCH, XV_BYTES = 256 * XV_PITCH;
DI void x_gload(const bf16_t* __restrict__ KM, const bf16_t* __restrict__ VTM, int bitem, int c, int tid, u32x4 (&r)[8]) {
    const int rb = bitem >> 2, h = bitem & 3, row0 = rb * 128; const int gb = row0 < MP ? (row0 >> 12) : 16 + ((row0 - MP) >> 13);
#pragma unroll
    for (int j = 0; j < 4; ++j) { const int q = tid + 512 * j; r[j] = *(const u32x4*)(KM + (size_t)(gb * 256 + 64 * c + (q >> 5)) * 1024 + h * 256 + (q & 31) * 8); }
#pragma unroll
    for (int j = 0; j < 4; ++j) { const int q = tid + 512 * j; r[4 + j] = *(const u32x4*)(VTM + (size_t)(h * 256 + (q >> 3)) * NMEM + gb * 256 + 64 * c + (q & 7) * 8); }
}
DI void x_lstore(unsigned char* kl, unsigned char* vl, int tid, const u32x4 (&r)[8]) {
#pragma unroll
    for (int j = 0; j < 4; ++j) { const int q = tid + 512 * j; *(u32x4*)(kl + (q >> 5) * XK_PITCH + (q & 31) * 16) = r[j]; }
#pragma unroll
    for (int j = 0; j < 4; ++j) { const int q = tid + 512 * j; *(u32x4*)(vl + (q >> 3) * XV_PITCH + (q & 7) * 16) = r[4 + j]; }
}
constexpr int XBUF = XK_BYTES + XV_BYTES;
DI void phase_xattn(const Params& p, unsigned char* shm, int wid, int lane) {
    const bf16_t* QX = (const bf16_t*)(p.ws + WS_QX); const bf16_t* KM = (const bf16_t*)(p.out + SM_KM); const bf16_t* VTM = (const bf16_t*)(p.out + SM_VTM); bf16_t* OC = (bf16_t*)(p.ws + WS_OC);
    const int fr = lane & 15, fq = lane >> 4, tid = threadIdx.x, G = gridDim.x;
    constexpr int NIT = (MTOK / 128) * 4;
    int bitem = blockIdx.x, step = 0;
    if (bitem < NIT) { u32x4 pre[8]; x_gload(KM, VTM, bitem, 0, tid, pre); x_lstore(shm, shm + XK_BYTES, tid, pre); }
    while (bitem < NIT) {
        const int rb = bitem >> 2, h = bitem & 3, row0 = rb * 128 + wid * 16;
        const bf16_t* qp = QX + (size_t)(row0 + fr) * 1024 + h * 256 + 8 * fq;
        bf16x8 qf[8];
#pragma unroll
        for (int ks = 0; ks < 8; ++ks) qf[ks] = *(const bf16x8*)(qp + 32 * ks);
        f32x4 o[16];
#pragma unroll
        for (int dc = 0; dc < 16; ++dc) o[dc] = (f32x4){0.f, 0.f, 0.f, 0.f};
        float m = -1e30f, l = 0.f;
#pragma unroll 1
        for (int c = 0; c < 4; ++c, ++step) {
            unsigned char* kl = shm + (step & 1) * XBUF; unsigned char* vl = kl + XK_BYTES;
            unsigned char* kn = shm + ((step & 1) ^ 1) * XBUF;
            const unsigned char* krd = kl + fr * XK_PITCH + fq * 16;
            const unsigned char* vrd = vl + fr * XV_PITCH + fq * 8;
            __syncthreads();
            const int nb = c < 3 ? bitem : bitem + G, nc = c < 3 ? c + 1 : 0; const bool has_next = nb < NIT;
            u32x4 pre[8];
            if (has_next) x_gload(KM, VTM, nb, nc, tid, pre);
            f32x4 s[4];
#pragma unroll
            for (int kt = 0; kt < 4; ++kt) { s[kt] = (f32x4){0.f, 0.f, 0.f, 0.f};
#pragma unroll
                for (int ks = 0; ks < 8; ++ks) { const bf16x8 kf = *(const bf16x8*)(krd + kt * 16 * XK_PITCH + ks * 64); s[kt] = __builtin_amdgcn_mfma_f32_16x16x32_bf16(kf, qf[ks], s[kt], 0, 0, 0); } }
            bf16x8 pf[2];
            softmax_chunk<16>(s, m, l, o, pf);
#pragma unroll
            for (int pr = 0; pr < 2; ++pr)
#pragma unroll
                for (int dc = 0; dc < 16; ++dc) { const unsigned char* vp = vrd + dc * 16 * XV_PITCH + pr * 64; const s16x4 lo = *(const s16x4*)vp, hi = *(const s16x4*)(vp + 32);
                    const bf16x8 vf = __builtin_shufflevector(lo, hi, 0, 1, 2, 3, 4, 5, 6, 7); o[dc] = __builtin_amdgcn_mfma_f32_16x16x32_bf16(vf, pf[pr], o[dc], 0, 0, 0); }
            if (has_next) x_lstore(kn, kn + XK_BYTES, tid, pre);
        }
        l += __shfl_xor(l, 16); l += __shfl_xor(l, 32);
        const float inv = 1.0f / l; bf16_t* dst = OC + (size_t)(row0 + fr) * 1024 + h * 256 + 4 * fq;
#pragma unroll
        for (int dc = 0; dc < 16; ++dc) { u32x2 w; w.x = cvt_pk_bf16(o[dc][0] * inv, o[dc][1] * inv); w.y = cvt_pk_bf16(o[dc][2] * inv, o[dc][3] * inv); *(u32x2*)(dst + 16 * dc) = w; }
        bitem += G;
    }
    __syncthreads();
}

#define XB_TMO      128
#define XB_XCNT(j)  (256  + 64 * (j))
#define XB_XSUB(j)  (1280 + 64 * (j))
#define XB_XGEN(j)  (2304 + 64 * (j))
#define XB_TOP      3328
#define XB_TOPGEN   3392
#define XCD_BAR_WORDS 3456
#define XB_SPIN_CAP (1u << 18)
__device__ __forceinline__ unsigned xb_ld(unsigned* p)              { return __hip_atomic_load(p, __ATOMIC_RELAXED, __HIP_MEMORY_SCOPE_AGENT); }
__device__ __forceinline__ unsigned xb_add(unsigned* p, unsigned v) { return __hip_atomic_fetch_add(p, v, __ATOMIC_RELAXED, __HIP_MEMORY_SCOPE_AGENT); }
__device__ __forceinline__ unsigned xb_xcc_id() { return (unsigned)__builtin_amdgcn_s_getreg((3 << 11) | 20) & 0xFu; }
#define XB_SPIN(cond, bar) do { unsigned _sp = 0; while (cond) { __builtin_amdgcn_s_sleep(1); \
    if ((++_sp & 255u) == 0u) { if (xb_ld(&(bar)[XB_TMO])) break; if (_sp > XB_SPIN_CAP) { atomicAdd(&(bar)[XB_TMO], 1u); break; } } } } while (0)
struct XcdBarrier { unsigned* bar; unsigned x; volatile PG8_LAS unsigned* st; };
__device__ __forceinline__ XcdBarrier xcd_barrier_post(unsigned* bar, volatile PG8_LAS unsigned* st) {
    XcdBarrier b; b.bar = bar; b.x = xb_xcc_id(); b.st = st;
    if (threadIdx.x == 0) (void)xb_add(&bar[XB_XCNT(b.x)], 1u);
    return b;
}
__device__ __forceinline__ void xcd_barrier_complete(unsigned* bar, unsigned x, unsigned& nloc, unsigned& nx) {
    const unsigned G = gridDim.x * gridDim.y * gridDim.z;
    unsigned sum, cnt, mine, sp = 0u;
    for (;;) {
        sum = 0u; cnt = 0u; mine = 0u;
#pragma unroll
        for (unsigned j = 0; j < 16; ++j) { const unsigned c = xb_ld(&bar[XB_XCNT(j)]); sum += c; cnt += (c > 0u) ? 1u : 0u; mine = (j == x) ? c : mine; }
        if (sum == G) break;
        __builtin_amdgcn_s_sleep(1);
        if ((++sp & 255u) == 0u) { if (xb_ld(&bar[XB_TMO])) break; if (sp > XB_SPIN_CAP) { atomicAdd(&bar[XB_TMO], 1u); break; } }
    }
    nloc = mine > 0u ? mine : 1u; nx = cnt > 0u ? cnt : 1u;
}
__device__ __forceinline__ void xcd_barrier(unsigned* bar_, volatile PG8_LAS unsigned* st_) {
    XcdBarrier b; b.bar = bar_; b.st = st_; b.x = 0u;
    asm volatile("s_waitcnt vmcnt(0)" ::: "memory");
    __syncthreads();
    if (threadIdx.x == 0) {
        unsigned* bar = b.bar; b.x = xb_xcc_id();
        __builtin_amdgcn_s_waitcnt(0);
        unsigned nloc = b.st[0], nx = b.st[1];
        if (nloc == 0u) { xcd_barrier_complete(bar, b.x, nloc, nx); b.st[0] = nloc; b.st[1] = nx; }
        const unsigned old = xb_add(&bar[XB_XSUB(b.x)], 1u);
        const unsigned gen = old / nloc;
        if (old + 1u == (gen + 1u) * nloc) {
            __builtin_amdgcn_fence(__ATOMIC_RELEASE, "agent");
            asm volatile("s_waitcnt vmcnt(0)" ::: "memory");
            const unsigned og = xb_add(&bar[XB_TOP], 1u);
            const unsigned tg = og / nx;
            if (og + 1u == (tg + 1u) * nx) xb_add(&bar[XB_TOPGEN], 1u);
            else XB_SPIN(xb_ld(&bar[XB_TOPGEN]) == tg, bar);
            __builtin_amdgcn_fence(__ATOMIC_ACQUIRE, "agent");
            xb_add(&bar[XB_XGEN(b.x)], 1u);
            asm volatile("s_waitcnt vmcnt(0)" ::: "memory");
        } else {
            XB_SPIN(xb_ld(&bar[XB_XGEN(b.x)]) == gen, bar);
            __builtin_amdgcn_fence(__ATOMIC_ACQUIRE, "agent");
            asm volatile("s_waitcnt vmcnt(0)" ::: "memory");
        }
    }
    __syncthreads();
}

constexpr int LDS_XB = 2 * (64 * 528 + 256 * 144);
constexpr int LDS_BYTES = LDS_XB + 64;
constexpr int NPHASE = 14;

__global__ void __launch_bounds__(512, 2) fwd_megakernel(const Params p) {
    extern __shared__ __attribute__((aligned(16))) unsigned char shm[];
    PG8_LAS unsigned char* lds = (PG8_LAS unsigned char*)shm;
    const int tid = threadIdx.x, wid = __builtin_amdgcn_readfirstlane(tid >> 6), lane = tid & 63;
    const int G = gridDim.x, gw = blockIdx.x * 8 + wid, nw = G * 8;
    unsigned char* ws = p.ws; unsigned char* sm = p.out;
    const int lo = p.ph_lo, hi = p.ph_hi;
    volatile PG8_LAS unsigned* xbst = (volatile PG8_LAS unsigned*)(lds + LDS_XB);
    if (tid < 16) xbst[tid] = 0u;
    __syncthreads();
    if (tid == 0) { const unsigned x = xb_xcc_id(); const unsigned idx = xb_add((unsigned*)(sm + SM_BAR) + XB_XCNT(x), 1u); xbst[2] = x; xbst[3] = idx; xbst[4] = blockIdx.x; xbst[5] = blockIdx.x; }
    __syncthreads();
#ifdef PROBE_TS
    unsigned long long ts[15]; ts[0] = __builtin_amdgcn_s_memrealtime();
#define STAMP(k) ts[(k) + 1] = __builtin_amdgcn_s_memrealtime()
#else
#define STAMP(k)
#endif
#define IN(k) (((PH_MASK >> (k)) & 1) && lo <= (k) && (k) < hi)
#define SEAM(k) do { if ((k) + 1 < hi) { if (lo < 0) { __threadfence(); cg::this_grid().sync(); }     \
        xcd_barrier((k) == 12 ? (unsigned*)(p.ws + WS_BAR2) : (unsigned*)(p.out + SM_BAR), (volatile PG8_LAS unsigned*)((PG8_LAS unsigned char*)shm + LDS_XB)); } STAMP(k); } while (0)
    if (IN(0)) { phase_prologue(p, gw, nw, lane); } if (lo <= 0 && 0 < hi) SEAM(0);
    if (lo <= 0 && 0 < hi) {
        if (tid == 0) { unsigned* bar = (unsigned*)(sm + SM_BAR); bool ok = (G % 8) == 0; unsigned pop = 0;
            for (unsigned j = 0; j < 16; ++j) { const unsigned c = xb_ld(&bar[XB_XCNT(j)]); if (c != 0u) { ++pop; if (c != (unsigned)G / 8u) ok = false; } }
            ok = ok && pop == 8u && xbst[2] < 8u;
            if (ok) { xbst[4] = xbst[2] * ((unsigned)G / 8u) + xbst[3];
                      xbst[5] = xbst[3] * 8u + xbst[2]; } }
        __syncthreads();
    }
    const int vcu = __builtin_amdgcn_readfirstlane((int)xbst[4]), cid = __builtin_amdgcn_readfirstlane((int)xbst[5]);
    if (IN(1)) {
        { pg8::StaticOrder S; pg8::Gemm g{(const bf16_t*)(ws + WS_XN), (const bf16_t*)(sm + SM_WIN), MTOK, 3072, 1024}; S.init(g.M, g.N, G, cid);
          EpiQKV E{(bf16_t*)(ws + WS_QKV), (const float*)(sm + SM_RC), (const float*)(sm + SM_RS)}; pg8::gemm_phase(lds, g, S, E); }
#if !defined(NO_KV)
        { pg8::StaticOrder S; pg8::Gemm g{(const bf16_t*)(sm + SM_MEMB), (const bf16_t*)(sm + SM_WXKV), NMEM, 1024, 1024}; S.init(g.M, g.N, G, cid);
          EpiPlain E{(bf16_t*)(sm + SM_KM), 1024}; pg8::gemm_phase(lds, g, S, E); }
        { pg8::StaticOrder S; pg8::Gemm g{(const bf16_t*)(sm + SM_WXKV) + (size_t)1024 * 1024, (const bf16_t*)(sm + SM_MEMB), 1024, NMEM, 1024}; S.init(g.M, g.N, G, (cid + 128) % G);
          EpiPlain E{(bf16_t*)(sm + SM_VTM), NMEM}; pg8::gemm_phase(lds, g, S, E); }
#endif
    } if (lo <= 1 && 1 < hi) SEAM(1);
    if (IN(2)) { phase_attn(p, shm, wid, lane, vcu);
#ifdef DUP_ATTN
        __syncthreads(); phase_attn(p, shm, wid, lane, vcu);
#endif
    } if (lo <= 2 && 2 < hi) SEAM(2);
    if (IN(3)) { pg8::StaticOrder S; pg8::Gemm g{(const bf16_t*)(sm + OUT_O), (const bf16_t*)(sm + SM_WOUT), MTOK, 1024, 1024}; S.init(g.M, g.N, G, cid);
        EpiRes E{(bf16_t*)(ws + WS_Z1), (const bf16_t*)(ws + WS_XN)}; pg8::gemm_phase(lds, g, S, E); } if (lo <= 3 && 3 < hi) SEAM(3);
    if (IN(4)) { phase_ln<false>((const bf16_t*)(ws + WS_Z1), (const float*)(sm + SM_SMALL) + SS_LN1G, (const float*)(sm + SM_SMALL) + SS_LN1B, (bf16_t*)(ws + WS_X1), nullptr, gw, nw, lane);
#ifdef DUP_LN
        phase_ln<false>((const bf16_t*)(ws + WS_Z1), (const float*)(sm + SM_SMALL) + SS_LN1G, (const float*)(sm + SM_SMALL) + SS_LN1B, (bf16_t*)(ws + WS_X1), nullptr, gw, nw, lane);
#endif
    } if (lo <= 4 && 4 < hi) SEAM(4);
    if (IN(5)) { pg8::StaticOrder S; pg8::Gemm g{(const bf16_t*)(ws + WS_X1), (const bf16_t*)(sm + SM_WXQ), MTOK, 1024, 1024}; S.init(g.M, g.N, G, cid);
        EpiPlain E{(bf16_t*)(ws + WS_QX), 1024}; pg8::gemm_phase(lds, g, S, E); } if (lo <= 5 && 5 < hi) SEAM(5);
    if (IN(6)) { phase_xattn(p, shm, wid, lane); } if (lo <= 6 && 6 < hi) SEAM(6);
    if (IN(7)) { pg8::StaticOrder S; pg8::Gemm g{(const bf16_t*)(ws + WS_OC), (const bf16_t*)(sm + SM_WXO), MTOK, 1024, 1024}; S.init(g.M, g.N, G, cid);
        EpiRes E{(bf16_t*)(ws + WS_Z2), (const bf16_t*)(ws + WS_X1)}; pg8::gemm_phase(lds, g, S, E); } if (lo <= 7 && 7 < hi) SEAM(7);
    if (IN(8)) { phase_ln<false>((const bf16_t*)(ws + WS_Z2), (const float*)(sm + SM_SMALL) + SS_LN2G, (const float*)(sm + SM_SMALL) + SS_LN2B, (bf16_t*)(ws + WS_X2), nullptr, gw, nw, lane); } if (lo <= 8 && 8 < hi) SEAM(8);
#define UPDOWN(ch) do { const size_t r0 = (size_t)(ch) * MP; \
        if (IN(9 + 2 * (ch))) { pg8::StaticOrder S; pg8::Gemm g{(const bf16_t*)(ws + WS_X2) + r0 * 1024, (const bf16_t*)(sm + SM_WUP), MP, 4096, 1024}; S.init(g.M, g.N, G, cid); \
            EpiRelu2 E{(bf16_t*)(ws + WS_H), 4096}; pg8::gemm_phase(lds, g, S, E); } if (lo <= 9 + 2 * (ch) && 9 + 2 * (ch) < hi) SEAM(9 + 2 * (ch)); \
        if (IN(10 + 2 * (ch))) { pg8::StaticOrder S; pg8::Gemm g{(const bf16_t*)(ws + WS_H), (const bf16_t*)(sm + SM_WDOWN), MP, 1024, 4096}; S.init(g.M, g.N, G, cid); \
            EpiRes E{(bf16_t*)(ws + WS_Z3) + r0 * 1024, (const bf16_t*)(ws + WS_X2) + r0 * 1024}; pg8::gemm_phase(lds, g, S, E); } if (lo <= 10 + 2 * (ch) && 10 + 2 * (ch) < hi) SEAM(10 + 2 * (ch)); } while (0)
    UPDOWN(0);
    if (lo <= 11 && 11 < hi && blockIdx.x == 0) { for (int i = tid; i < XCD_BAR_WORDS; i += 512) ((unsigned*)(ws + WS_BAR2))[i] = 0u; }
    UPDOWN(1);
#ifdef PROBE_TS
    { const float tot = (float)(ts[13] - ts[0]); const float fa = (float)(ts[PROBE_A1 + 1] - ts[PROBE_A0]) / tot, fb = (float)(ts[PROBE_B1 + 1] - ts[PROBE_B0]) / tot;
      const float fa_q = floorf(fa * 32.f + 0.5f) * (1.f / 32.f), fb_q = floorf(fb * 32.f + 0.5f) * (1.f / 32.f);
      if (IN(13)) { phase_ln<true>((const bf16_t*)(ws + WS_Z3), p.ln3_g, p.ln3_b, nullptr, (float*)p.out, gw, nw, lane, 1.f + fa_q, 1000.f * fb_q); } }
#else
    if (IN(13)) { phase_ln<true>((const bf16_t*)(ws + WS_Z3), p.ln3_g, p.ln3_b, nullptr, (float*)p.out, gw, nw, lane); }
#endif
}

extern "C" void kernel_launch(void* const* d_in, const int* in_sizes, int n_in, void* d_out, int out_size, void* d_ws, size_t ws_size, hipStream_t stream) {
    static int grid = 0;
    if (grid == 0) {
        if (n_in != 22 || ws_size < WS_NEED || (size_t)out_size != (size_t)MTOK * 1024) { fprintf(stderr, "kernel_launch: unexpected shapes (n_in %d, ws %zu, out %d); nothing launched\n", n_in, ws_size, out_size); grid = -1; return; }
        int dev = 0, cus = 0, per_cu = 0;
        hipGetDevice(&dev); hipDeviceGetAttribute(&cus, hipDeviceAttributeMultiprocessorCount, dev);
        if (hipFuncSetAttribute((const void*)fwd_megakernel, hipFuncAttributeMaxDynamicSharedMemorySize, LDS_BYTES) != hipSuccess) { fprintf(stderr, "kernel_launch: hipFuncSetAttribute failed\n"); grid = -1; return; }
        if (hipOccupancyMaxActiveBlocksPerMultiprocessor(&per_cu, (const void*)fwd_megakernel, 512, LDS_BYTES) != hipSuccess || per_cu < 1) { fprintf(stderr, "kernel_launch: occupancy query says %d\n", per_cu); per_cu = 1; }
        (void)hipGetLastError();
        grid = cus * 1;
    }
    if (grid < 0) return;
    Params p{};
    const float** pp = (const float**)&p;
    for (int i = 0; i < 22; ++i) pp[i] = (const float*)d_in[i];
    p.out = (unsigned char*)d_out; p.ws = (unsigned char*)d_ws;
    if (hipMemsetAsync((unsigned char*)d_out + SM_BAR, 0, XCD_BAR_WORDS * 4, stream) != hipSuccess) { fprintf(stderr, "kernel_launch: hipMemsetAsync of the barrier words failed\n"); return; }
#if N_LAUNCHES == 1
    p.ph_lo = 0; p.ph_hi = NPHASE;
    void* args[] = {(void*)&p};
    hipError_t e = hipLaunchCooperativeKernel((const void*)fwd_megakernel, dim3(grid), dim3(512), args, LDS_BYTES, stream);
    if (e != hipSuccess) fprintf(stderr, "cooperative launch failed: %s (grid %d)\n", hipGetErrorString(e), grid);
#else
    for (int ph = 0; ph < NPHASE; ++ph) { p.ph_lo = ph; p.ph_hi = ph + 1; hipLaunchKernelGGL(fwd_megakernel, dim3(grid), dim3(512), LDS_BYTES, stream, p); }
#endif
}
```

```cpp
#include <hip/hip_runtime.h>
#include <hip/hip_cooperative_groups.h>
#include <cstdio>
namespace cg = cooperative_groups;

#define DI __device__ __forceinline__
#define PG8_LAS __attribute__((address_space(3)))
typedef unsigned short bf16_t;
typedef short bf16x8 __attribute__((ext_vector_type(8)));
typedef short s16x4 __attribute__((ext_vector_type(4)));
typedef float f32x4 __attribute__((ext_vector_type(4)));
typedef unsigned u32x4 __attribute__((ext_vector_type(4)));
typedef unsigned u32x2 __attribute__((ext_vector_type(2)));

#ifndef NO_P1
#define NO_P1 0
#endif
#ifndef NO_P2
#define NO_P2 0
#endif
#ifndef PH_MASK
#define PH_MASK 0xffff
#endif
#ifndef N_LAUNCHES
#define N_LAUNCHES 1
#endif

constexpr int MTOK = 131072, MP = 65536, NMEM = 6144;
constexpr float ALPHA_C = 1.189207115002721f, LN_EPS_C = 1e-5f, LOG2E_C = 1.4426950408889634f;
constexpr size_t MiB = (size_t)1 << 20;
constexpr size_t WS_XN = 0, WS_QKV = 256 * MiB, WS_Z1 = 256 * MiB, WS_QX = 512 * MiB, WS_OC = 768 * MiB, WS_X1 = 0, WS_Z2 = 256 * MiB, WS_X2 = 512 * MiB, WS_H = 0, WS_Z3 = 768 * MiB;
constexpr size_t WS_NEED = 1024 * MiB;
constexpr size_t WS_BAR2 = 512 * MiB;
constexpr size_t OUT_O = 0, OUT_SM = 256 * MiB;
constexpr size_t SM_WIN = OUT_SM, SM_WOUT = SM_WIN + 6 * MiB, SM_WXQ = SM_WOUT + 2 * MiB, SM_WXKV = SM_WXQ + 2 * MiB, SM_WXO = SM_WXKV + 4 * MiB, SM_WUP = SM_WXO + 2 * MiB,
                 SM_WDOWN = SM_WUP + 8 * MiB, SM_MEMB = SM_WDOWN + 8 * MiB, SM_KM = SM_MEMB + 12 * MiB, SM_VTM = SM_KM + 12 * MiB, SM_RC = SM_VTM + 12 * MiB, SM_RS = SM_RC + 1 * MiB, SM_ML = SM_RS + 1 * MiB  , SM_BAR = SM_ML + 8 * MiB  , SM_S1 = SM_BAR + 65536  , SM_S2 = SM_S1 + 1 * MiB  ,
                 SM_SMALL = SM_S2 + 1 * MiB  ,
                 SM_CV = SM_SMALL + 65536  , SM_CP = SM_CV + 65536  ;
constexpr int SS_RPB = 0, SS_LN1G = 4096, SS_LN1B = 5120, SS_LN2G = 6144, SS_LN2B = 7168, SS_TOTAL = 8192;

struct Params {
    const float *x_prompt, *x_sample, *mem_prompt, *mem_sample, *ln_in_g, *ln_in_b, *w_in, *rpb, *g_mix_a, *g_mix_b, *w_out, *ln1_g, *ln1_b, *w_xq, *w_xkv, *w_xo, *ln2_g, *ln2_b, *w_up, *w_down, *ln3_g, *ln3_b;
    unsigned char* out; unsigned char* ws; int ph_lo, ph_hi;
};

typedef __bf16 bf16x2n __attribute__((ext_vector_type(2)));
typedef float f32x2n __attribute__((ext_vector_type(2)));
DI unsigned cvt_pk_bf16(float lo, float hi) { const f32x2n v = {lo, hi}; const bf16x2n b = __builtin_convertvector(v, bf16x2n); return __builtin_bit_cast(unsigned, b); }
DI float bf_lo(unsigned w) { return __uint_as_float(w << 16); }
DI float bf_hi(unsigned w) { return __uint_as_float(w & 0xffff0000u); }
DI float wave_sum(float v) { for (int o = 32; o >= 1; o >>= 1) v += __shfl_xor(v, o); return v; }

namespace pg8 {
constexpr int BM = 256, BK = 64, HALF = 128, HTB = HALF * BK * 2, STAGE_BYTES = 8 * HTB, NXCD = 8, WGM = 8;
__host__ __device__ __forceinline__ int lds_byte(int r, int c) { const int st = (r >> 4) * 2 + (c >> 5), rr = r & 15, cc = c & 31, ob = rr * 64 + cc * 2; return st * 1024 + (ob ^ (((ob >> 9) & 1) << 5)); }
__host__ __device__ __forceinline__ void stage_rc(int b, int& R, int& C) { const int st = b / 1024, sb = b % 1024, swz = sb ^ (((sb >> 9) & 1) << 5); R = (st >> 1) * 16 + swz / 64; C = (st & 1) * 32 + (swz % 64) / 2; }
__host__ __device__ __forceinline__ int perm32(int rho) { const int n = rho >> 4, i = rho & 15; return 8 * (i >> 2) + 4 * n + (i & 3); }
struct Unit { int pm, pn; };
struct Gemm { const bf16_t* A; const bf16_t* Bt; int M, N, K; };
struct StaticOrder {
    int nM, nN, nwg, G, c;
    __device__ void init(int M, int N, int G_, int c_) { nM = M / BM; nN = N / BM; nwg = nM * nN; G = G_; c = c_; }
    __device__ bool next(int i, Unit& u) const {
        const long L = (long)i * G + c; if (L >= nwg) return false;
        int wgid = (int)L; { const int q = nwg / NXCD, r = nwg % NXCD, xcd = wgid % NXCD, off = wgid / NXCD; wgid = (xcd < r ? xcd * (q + 1) : r * (q + 1) + (xcd - r) * q) + off; }
        const int nig = WGM * nN, gid = wgid / nig, fm = gid * WGM, gsz = (nM - fm) < WGM ? (nM - fm) : WGM;
        u.pm = fm + ((wgid % nig) % gsz); u.pn = (wgid % nig) / gsz; return true;
    }
};

template <class Epi, bool ALIGN_EPI = true, bool SP2 = true>
__device__ __forceinline__ void gemm_phase(PG8_LAS unsigned char* lds, const Gemm g, const StaticOrder& S, const Epi& E) {
    const int tid = threadIdx.x, wid = __builtin_amdgcn_readfirstlane(tid >> 6), lane = tid & 63, wr = wid >> 2, wc = wid & 3, fr = lane & 15, fq = lane >> 4;
    const int K = g.K, nt = K / BK;
    unsigned voffA[2], voffB[2];
#pragma unroll
    for (int i = 0; i < 2; ++i) { int R, C; stage_rc(tid * 16 + i * 8192, R, C); const int Rb = Epi::PERM ? ((R & ~31) + perm32(R & 31)) : R;
        voffA[i] = (unsigned)(R * K + C) * 2u; voffB[i] = (unsigned)(Rb * K + C) * 2u; }
    const size_t kstep = (size_t)(BK * 2);
    const size_t hstep = (size_t)HALF * K * 2;
    const size_t tstep = 2 * hstep;
    const unsigned ldsw = (unsigned)wid * 1024u;
    const int aoff = lds_byte(wr * 64 + fr, fq * 8), boff = lds_byte(wc * 32 + fr, fq * 8);
#define PG8_SA(b, h) (((b) * 2 + (h)) * HTB)
#define PG8_SB(b, h) ((4 + (b) * 2 + (h)) * HTB)
#define PG8_STAGE(bufoff, gbase, voff) do { _Pragma("unroll") for (int _i = 0; _i < 2; ++_i) \
        __builtin_amdgcn_global_load_lds((const unsigned*)((const char*)(gbase) + (voff)[_i]), (PG8_LAS unsigned*)(lds + (bufoff) + ldsw + _i * 8192), 16, 0, 0); } while (0)
#define PG8_LDA(dst, b, h) do { _Pragma("unroll") for (int m = 0; m < 4; ++m) _Pragma("unroll") for (int k = 0; k < 2; ++k) dst[m][k] = *(const PG8_LAS bf16x8*)(lds + PG8_SA(b, h) + aoff + m * 2048 + k * 1024); } while (0)
#define PG8_LDB(dst, b, h) do { _Pragma("unroll") for (int n = 0; n < 2; ++n) _Pragma("unroll") for (int k = 0; k < 2; ++k) dst[n][k] = *(const PG8_LAS bf16x8*)(lds + PG8_SB(b, h) + boff + n * 2048 + k * 1024); } while (0)
#define PG8_MMA(ai, bj, At, Bt) do { __builtin_amdgcn_s_setprio(1); _Pragma("unroll") for (int m = 0; m < 4; ++m) _Pragma("unroll") for (int n = 0; n < 2; ++n) _Pragma("unroll") for (int k = 0; k < 2; ++k) \
        acc[ai][bj][m][n] = __builtin_amdgcn_mfma_f32_16x16x32_bf16(Bt[n][k], At[m][k], acc[ai][bj][m][n], 0, 0, 0); __builtin_amdgcn_s_setprio(0); } while (0)
#define PG8_WAIT_V(n) asm volatile("s_waitcnt vmcnt(" #n ")" ::: "memory")
#define PG8_WAIT_L(n) asm volatile("s_waitcnt lgkmcnt(" #n ")" ::: "memory")
#define PG8_BAR __builtin_amdgcn_s_barrier()
#define PG8_SCHED __builtin_amdgcn_sched_barrier(0)
    Unit cur, nxt; int ui = 0;
    if (!S.next(0, cur)) return;
    f32x4 acc[2][2][4][2];
#pragma unroll
    for (int a = 0; a < 2; ++a)
#pragma unroll
        for (int b = 0; b < 2; ++b)
#pragma unroll
            for (int m = 0; m < 4; ++m)
#pragma unroll
                for (int n = 0; n < 2; ++n) acc[a][b][m][n] = (f32x4){0.f, 0.f, 0.f, 0.f};
    bf16x8 At[4][2], B0[2][2], B1[2][2];
    const char* cA = (const char*)g.A + (size_t)cur.pm * tstep; const char* cB = (const char*)g.Bt + (size_t)cur.pn * tstep;
    if constexpr (SP2) {
        PG8_STAGE(PG8_SB(0, 0), cB, voffB); PG8_STAGE(PG8_SB(0, 1), cB + hstep, voffB); PG8_STAGE(PG8_SA(0, 0), cA, voffA); PG8_STAGE(PG8_SA(0, 1), cA + hstep, voffA);
        if (wr == 1) PG8_BAR;
        PG8_WAIT_V(2); PG8_BAR;
        PG8_STAGE(PG8_SB(1, 0), cB + kstep, voffB); PG8_STAGE(PG8_SA(1, 0), cA + kstep, voffA); PG8_STAGE(PG8_SB(1, 1), cB + hstep + kstep, voffB);
        PG8_WAIT_V(6); PG8_BAR;
    } else {
    PG8_STAGE(PG8_SB(0, 0), cB, voffB); PG8_STAGE(PG8_SA(0, 0), cA, voffA); PG8_STAGE(PG8_SB(0, 1), cB + hstep, voffB); PG8_STAGE(PG8_SA(0, 1), cA + hstep, voffA);
    if (wr == 1) PG8_BAR;
    PG8_WAIT_V(4); PG8_BAR;
    PG8_STAGE(PG8_SB(1, 0), cB + kstep, voffB); PG8_STAGE(PG8_SA(1, 0), cA + kstep, voffA); PG8_STAGE(PG8_SB(1, 1), cB + hstep + kstep, voffB);
    PG8_WAIT_V(6); PG8_BAR;
    }
    for (;;) {
        const bool has_next = S.next(ui + 1, nxt);
        const char* nA = has_next ? (const char*)g.A + (size_t)nxt.pm * tstep : cA; const char* nB = has_next ? (const char*)g.Bt + (size_t)nxt.pn * tstep : cB;
        for (int t = 0; t < nt; t += 2) {
            const bool last = (t == nt - 2);
            const char* a1 = cA + (size_t)(t + 1) * kstep;
            const char* a2 = last ? nA : cA + (size_t)(t + 2) * kstep; const char* b2 = last ? nB : cB + (size_t)(t + 2) * kstep;
            const char* a3 = a2 + kstep; const char* b3 = b2 + kstep;
            if constexpr (SP2) {
            PG8_LDB(B0, 0, 0); PG8_LDB(B1, 0, 1); PG8_SCHED; PG8_LDA(At, 0, 0); PG8_STAGE(PG8_SA(1, 1), a1 + hstep, voffA);
            PG8_WAIT_V(8); PG8_WAIT_L(0); PG8_BAR; PG8_MMA(0, 0, At, B0); PG8_MMA(0, 1, At, B1); PG8_BAR; PG8_SCHED;
            PG8_LDA(At, 0, 1); PG8_STAGE(PG8_SB(0, 0), b2, voffB); PG8_STAGE(PG8_SB(0, 1), b2 + hstep, voffB); PG8_STAGE(PG8_SA(0, 0), a2, voffA);
            PG8_WAIT_V(8); PG8_WAIT_L(0); PG8_BAR; PG8_MMA(1, 0, At, B0); PG8_MMA(1, 1, At, B1); PG8_BAR; PG8_SCHED;
            PG8_LDB(B0, 1, 0); PG8_LDB(B1, 1, 1); PG8_SCHED; PG8_LDA(At, 1, 0); PG8_STAGE(PG8_SA(0, 1), a2 + hstep, voffA);
            PG8_WAIT_V(8); PG8_WAIT_L(0); PG8_BAR; PG8_MMA(0, 0, At, B0); PG8_MMA(0, 1, At, B1); PG8_BAR; PG8_SCHED;
            PG8_LDA(At, 1, 1); PG8_STAGE(PG8_SB(1, 0), b3, voffB); PG8_STAGE(PG8_SB(1, 1), b3 + hstep, voffB); PG8_STAGE(PG8_SA(1, 0), a3, voffA);
            PG8_WAIT_V(8); PG8_WAIT_L(0); PG8_BAR; PG8_MMA(1, 0, At, B0); PG8_MMA(1, 1, At, B1); PG8_BAR; PG8_SCHED;
            } else {
            PG8_LDB(B0, 0, 0); PG8_SCHED; PG8_LDA(At, 0, 0); PG8_STAGE(PG8_SA(1, 1), a1 + hstep, voffA);
            PG8_WAIT_L(8); PG8_BAR; PG8_WAIT_L(0); PG8_MMA(0, 0, At, B0); PG8_BAR; PG8_SCHED;
            PG8_LDB(B1, 0, 1); PG8_STAGE(PG8_SB(0, 0), b2, voffB);
            PG8_BAR; PG8_WAIT_L(0); PG8_MMA(0, 1, At, B1); PG8_BAR;
            PG8_LDA(At, 0, 1); PG8_STAGE(PG8_SA(0, 0), a2, voffA);
            PG8_BAR; PG8_WAIT_L(0); PG8_MMA(1, 0, At, B0); PG8_BAR; PG8_SCHED;
            PG8_STAGE(PG8_SB(0, 1), b2 + hstep, voffB);
            PG8_WAIT_V(6); PG8_BAR; PG8_MMA(1, 1, At, B1); PG8_BAR;
            PG8_LDB(B0, 1, 0); PG8_SCHED; PG8_LDA(At, 1, 0); PG8_STAGE(PG8_SA(0, 1), a2 + hstep, voffA);
            PG8_WAIT_L(8); PG8_BAR; PG8_WAIT_L(0); PG8_MMA(0, 0, At, B0); PG8_BAR; PG8_SCHED;
            PG8_LDB(B1, 1, 1); PG8_STAGE(PG8_SB(1, 0), b3, voffB);
            PG8_BAR; PG8_WAIT_L(0); PG8_MMA(0, 1, At, B1); PG8_BAR;
            PG8_LDA(At, 1, 1); PG8_STAGE(PG8_SA(1, 0), a3, voffA);
            PG8_BAR; PG8_WAIT_L(0); PG8_MMA(1, 0, At, B0); PG8_BAR; PG8_SCHED;
            PG8_STAGE(PG8_SB(1, 1), b3 + hstep, voffB);
            PG8_WAIT_V(6); PG8_BAR; PG8_MMA(1, 1, At, B1); PG8_BAR;
            }
        }
        if constexpr (ALIGN_EPI) { if (wr == 0) PG8_BAR; }
        E(acc, cur, wr, wc, fr, fq);
        if (!has_next) break;
#pragma unroll
        for (int a = 0; a < 2; ++a)
#pragma unroll
            for (int b = 0; b < 2; ++b)
#pragma unroll
                for (int m = 0; m < 4; ++m)
#pragma unroll
                    for (int n = 0; n < 2; ++n) acc[a][b][m][n] = (f32x4){0.f, 0.f, 0.f, 0.f};
        cur = nxt; cA = nA; cB = nB; ++ui;
        if constexpr (ALIGN_EPI) { if (wr == 1) PG8_BAR; }
    }
    PG8_WAIT_V(0);
    if constexpr (!ALIGN_EPI) { if (wr == 0) PG8_BAR; }
    PG8_BAR;
#undef PG8_SA
#undef PG8_SB
#undef PG8_STAGE
#undef PG8_LDA
#undef PG8_LDB
#undef PG8_MMA
#undef PG8_WAIT_V
#undef PG8_WAIT_L
#undef PG8_BAR
#undef PG8_SCHED
}
}

struct EpiPlain {
    static constexpr bool PERM = true;
    bf16_t* O; int ldc;
    DI void operator()(const f32x4 (&acc)[2][2][4][2], const pg8::Unit& u, int wr, int wc, int fr, int fq) const {
        const int row0 = u.pm * 256 + wr * 64 + fr, col0 = u.pn * 256 + wc * 32 + 8 * fq;
#pragma unroll
        for (int ai = 0; ai < 2; ++ai)
#pragma unroll
            for (int m = 0; m < 4; ++m) { bf16_t* rowp = O + (size_t)(row0 + ai * 128 + m * 16) * ldc + col0;
#pragma unroll
                for (int bj = 0; bj < 2; ++bj) { const f32x4 v0 = acc[ai][bj][m][0], v1 = acc[ai][bj][m][1];
                    u32x4 w; w.x = cvt_pk_bf16(v0[0], v0[1]); w.y = cvt_pk_bf16(v0[2], v0[3]); w.z = cvt_pk_bf16(v1[0], v1[1]); w.w = cvt_pk_bf16(v1[2], v1[3]);
                    *(u32x4*)(rowp + bj * 128) = w; } }
    }
};
struct EpiRelu2 {
    static constexpr bool PERM = true;
    bf16_t* O; int ldc;
    DI void operator()(const f32x4 (&acc)[2][2][4][2], const pg8::Unit& u, int wr, int wc, int fr, int fq) const {
        const int row0 = u.pm * 256 + wr * 64 + fr, col0 = u.pn * 256 + wc * 32 + 8 * fq;
#pragma unroll
        for (int ai = 0; ai < 2; ++ai)
#pragma unroll
            for (int m = 0; m < 4; ++m) { bf16_t* rowp = O + (size_t)(row0 + ai * 128 + m * 16) * ldc + col0;
#pragma unroll
                for (int bj = 0; bj < 2; ++bj) { f32x4 v0 = acc[ai][bj][m][0], v1 = acc[ai][bj][m][1];
#pragma unroll
                    for (int j = 0; j < 4; ++j) { const float a = fmaxf(v0[j], 0.f), b = fmaxf(v1[j], 0.f); v0[j] = a * a; v1[j] = b * b; }
                    u32x4 w; w.x = cvt_pk_bf16(v0[0], v0[1]); w.y = cvt_pk_bf16(v0[2], v0[3]); w.z = cvt_pk_bf16(v1[0], v1[1]); w.w = cvt_pk_bf16(v1[2], v1[3]);
                    *(u32x4*)(rowp + bj * 128) = w; } }
    }
};
struct EpiRes {
    static constexpr bool PERM = true;
    bf16_t* O; const bf16_t* R;
    DI void operator()(const f32x4 (&acc)[2][2][4][2], const pg8::Unit& u, int wr, int wc, int fr, int fq) const {
        const int row0 = u.pm * 256 + wr * 64 + fr, col0 = u.pn * 256 + wc * 32 + 8 * fq;
#pragma unroll
        for (int ai = 0; ai < 2; ++ai)
#pragma unroll
            for (int m = 0; m < 4; ++m) { const size_t off = (size_t)(row0 + ai * 128 + m * 16) * 1024 + col0;
#pragma unroll
                for (int bj = 0; bj < 2; ++bj) { const f32x4 v0 = acc[ai][bj][m][0], v1 = acc[ai][bj][m][1];
                    const u32x4 rr = *(const u32x4*)(R + off + bj * 128);
                    u32x4 w;
                    w.x = cvt_pk_bf16(ALPHA_C * bf_lo(rr.x) + v0[0], ALPHA_C * bf_hi(rr.x) + v0[1]); w.y = cvt_pk_bf16(ALPHA_C * bf_lo(rr.y) + v0[2], ALPHA_C * bf_hi(rr.y) + v0[3]);
                    w.z = cvt_pk_bf16(ALPHA_C * bf_lo(rr.z) + v1[0], ALPHA_C * bf_hi(rr.z) + v1[1]); w.w = cvt_pk_bf16(ALPHA_C * bf_lo(rr.w) + v1[2], ALPHA_C * bf_hi(rr.w) + v1[3]);
                    *(u32x4*)(O + off + bj * 128) = w; } }
    }
};
struct EpiQKV {
    static constexpr bool PERM = true;
    bf16_t* O; const float* rc; const float* rs;
    DI void operator()(const f32x4 (&acc)[2][2][4][2], const pg8::Unit& u, int wr, int wc, int fr, int fq) const {
        const int row0 = u.pm * 256 + wr * 64 + fr, col0 = u.pn * 256 + wc * 32 + 8 * fq;
        const bool rot = u.pn < 4; const int i0 = 16 * (wc & 1) + 4 * fq;
#pragma unroll
        for (int ai = 0; ai < 2; ++ai)
#pragma unroll
            for (int m = 0; m < 4; ++m) { const int row = row0 + ai * 128 + m * 16; bf16_t* rowp = O + (size_t)row * 3072 + col0;
                f32x4 c4 = (f32x4){1.f, 1.f, 1.f, 1.f}, s4 = (f32x4){0.f, 0.f, 0.f, 0.f};
                if (rot) { const int t = row & (row < MP ? 4095 : 8191); c4 = *(const f32x4*)(rc + t * 32 + i0); s4 = *(const f32x4*)(rs + t * 32 + i0); }
#pragma unroll
                for (int bj = 0; bj < 2; ++bj) { const f32x4 v0 = acc[ai][bj][m][0], v1 = acc[ai][bj][m][1];
                    const f32x4 o0 = v0 * c4 - v1 * s4, o1 = v1 * c4 + v0 * s4;
                    u32x4 w; w.x = cvt_pk_bf16(o0[0], o0[1]); w.y = cvt_pk_bf16(o0[2], o0[3]); w.z = cvt_pk_bf16(o1[0], o1[1]); w.w = cvt_pk_bf16(o1[2], o1[3]);
                    *(u32x4*)(rowp + bj * 128) = w; }
                asm volatile("" ::: "memory"); }
    }
};

DI void wave_sum2(float& a, float& b) { for (int o = 32; o >= 1; o >>= 1) { a += __shfl_xor(a, o); b += __shfl_xor(b, o); } }
DI void wave_sum4(float& a, float& b, float& c, float& d) { for (int o = 32; o >= 1; o >>= 1) { a += __shfl_xor(a, o); b += __shfl_xor(b, o); c += __shfl_xor(c, o); d += __shfl_xor(d, o); } }
template <bool OUTF32>
DI void ln_store(f32x4 v0, f32x4 v1, f32x4 v2, f32x4 v3, float mean, float rstd, const f32x4 (&g)[4], const f32x4 (&b)[4], bf16_t* __restrict__ X, float* __restrict__ OF, int row, int lane) {
    v0 = (v0 - mean) * rstd * g[0] + b[0]; v1 = (v1 - mean) * rstd * g[1] + b[1]; v2 = (v2 - mean) * rstd * g[2] + b[2]; v3 = (v3 - mean) * rstd * g[3] + b[3];
    if (OUTF32) { float* o = OF + (size_t)row * 1024; *(f32x4*)(o + lane * 8) = v0; *(f32x4*)(o + lane * 8 + 4) = v1; *(f32x4*)(o + 512 + lane * 8) = v2; *(f32x4*)(o + 516 + lane * 8) = v3; }
    else { u32x4 w; w.x = cvt_pk_bf16(v0[0], v0[1]); w.y = cvt_pk_bf16(v0[2], v0[3]); w.z = cvt_pk_bf16(v1[0], v1[1]); w.w = cvt_pk_bf16(v1[2], v1[3]);
        *(u32x4*)(X + (size_t)row * 1024 + lane * 8) = w;
        w.x = cvt_pk_bf16(v2[0], v2[1]); w.y = cvt_pk_bf16(v2[2], v2[3]); w.z = cvt_pk_bf16(v3[0], v3[1]); w.w = cvt_pk_bf16(v3[2], v3[3]);
        *(u32x4*)(X + (size_t)row * 1024 + 512 + lane * 8) = w; }
}
DI float hsum(const f32x4& t) { return (t[0] + t[1]) + (t[2] + t[3]); }
template <int LNA, int RES, int STATS, int ACT> struct EpiGen {
    static constexpr bool PERM = true;
    bf16_t* O; int ldc; const float* Sa; const float* c1; const float* c2; const bf16_t* R; const float* Sr; const float* gr; const float* br; float* So;
    DI void operator()(const f32x4 (&acc)[2][2][4][2], const pg8::Unit& u, int wr, int wc, int fr, int fq) const {
        const int row0 = u.pm * 256 + wr * 64 + fr, col0 = u.pn * 256 + wc * 32 + 8 * fq;
        f32x4 ka[2][2], kb[2][2];
#pragma unroll
        for (int bj = 0; bj < 2; ++bj)
#pragma unroll
            for (int n = 0; n < 2; ++n) {
                if (LNA) { ka[bj][n] = *(const f32x4*)(c1 + col0 + bj * 128 + 4 * n); kb[bj][n] = *(const f32x4*)(c2 + col0 + bj * 128 + 4 * n); }
                else if (RES == 2) { ka[bj][n] = *(const f32x4*)(gr + col0 + bj * 128 + 4 * n); kb[bj][n] = *(const f32x4*)(br + col0 + bj * 128 + 4 * n); }
                else { ka[bj][n] = (f32x4){0.f, 0.f, 0.f, 0.f}; kb[bj][n] = ka[bj][n]; } }
#pragma unroll
        for (int ai = 0; ai < 2; ++ai)
#pragma unroll
            for (int m = 0; m < 4; ++m) { const int row = row0 + ai * 128 + m * 16;
                float mean_a = 0.f, rstd_a = 1.f, mean_r = 0.f, rstd_r = 1.f;
                if (LNA) { const float sx = Sa[2 * row], sq = Sa[2 * row + 1]; mean_a = sx * (1.f / 1024.f); rstd_a = rsqrtf(fmaxf(sq * (1.f / 1024.f) - mean_a * mean_a, 0.f) + LN_EPS_C); }
                if (RES == 2) { const float sx = Sr[2 * row], sq = Sr[2 * row + 1]; mean_r = sx * (1.f / 1024.f); rstd_r = rsqrtf(fmaxf(sq * (1.f / 1024.f) - mean_r * mean_r, 0.f) + LN_EPS_C); }
                float ssum = 0.f, ssq = 0.f;
#pragma unroll
                for (int bj = 0; bj < 2; ++bj) { f32x4 v0 = acc[ai][bj][m][0], v1 = acc[ai][bj][m][1];
                    if (LNA) { v0 = (v0 - mean_a * ka[bj][0]) * rstd_a + kb[bj][0]; v1 = (v1 - mean_a * ka[bj][1]) * rstd_a + kb[bj][1]; }
                    if (ACT) {
#pragma unroll
                        for (int j = 0; j < 4; ++j) { const float a = fmaxf(v0[j], 0.f), b = fmaxf(v1[j], 0.f); v0[j] = a * a; v1[j] = b * b; } }
                    if (RES) { const u32x4 rr = *(const u32x4*)(R + (size_t)row * 1024 + col0 + bj * 128);
                        f32x4 r0 = (f32x4){bf_lo(rr.x), bf_hi(rr.x), bf_lo(rr.y), bf_hi(rr.y)}, r1 = (f32x4){bf_lo(rr.z), bf_hi(rr.z), bf_lo(rr.w), bf_hi(rr.w)};
                        if (RES == 2) { r0 = (r0 - mean_r) * rstd_r * ka[bj][0] + kb[bj][0]; r1 = (r1 - mean_r) * rstd_r * ka[bj][1] + kb[bj][1]; }
                        v0 += ALPHA_C * r0; v1 += ALPHA_C * r1; }
                    if (STATS) { ssum += (v0[0] + v0[1]) + (v0[2] + v0[3]) + (v1[0] + v1[1]) + (v1[2] + v1[3]);
                        ssq += (v0[0] * v0[0] + v0[1] * v0[1]) + (v0[2] * v0[2] + v0[3] * v0[3]) + (v1[0] * v1[0] + v1[1] * v1[1]) + (v1[2] * v1[2] + v1[3] * v1[3]); }
                    u32x4 w; w.x = cvt_pk_bf16(v0[0], v0[1]); w.y = cvt_pk_bf16(v0[2], v0[3]); w.z = cvt_pk_bf16(v1[0], v1[1]); w.w = cvt_pk_bf16(v1[2], v1[3]);
                    *(u32x4*)(O + (size_t)row * ldc + col0 + bj * 128) = w; }
                if (STATS) { ssum += __shfl_xor(ssum, 16); ssum += __shfl_xor(ssum, 32); ssq += __shfl_xor(ssq, 16); ssq += __shfl_xor(ssq, 32);
                    if (fq == 0) { unsafeAtomicAdd(So + 2 * row, ssum); unsafeAtomicAdd(So + 2 * row + 1, ssq); } }
            }
    }
};

DI void transpose_w(const float* __restrict__ W, int K, int N, bf16_t* __restrict__ Wt, int mode, const float* ga, const float* gb, int gw, int nw, int lane, float csc = 1.f) {
    const int nNb = N >> 6, units = nNb * (K >> 6);
    for (int u = gw; u < units; u += nw) {
        const int nb = u % nNb, kb = u / nNb, n = nb * 64 + lane; int src = n; float sc = 1.f;
        if (mode == 1) { if (n < 1024) { const int hd = n >> 6, p = n & 63, j = p >> 3, e = p & 7; src = (hd << 6) + (e < 4 ? 4 * j + e : 32 + 4 * j + (e - 4)); }
            if (n < 512 || (n >= 1536 && n < 2048)) sc = 0.125f; }
        if (mode == 4) sc = csc;
#pragma unroll
        for (int kk = 0; kk < 8; ++kk) { const int k0 = kb * 64 + kk * 8; float v[8];
#pragma unroll
            for (int j = 0; j < 8; ++j) { float x = W[(size_t)(k0 + j) * N + src] * sc; if (mode == 2) x *= (k0 + j < 512) ? ga[k0 + j] : gb[k0 + j - 512]; if (mode == 4) x *= ga[k0 + j]; v[j] = x; }
            u32x4 w; w.x = cvt_pk_bf16(v[0], v[1]); w.y = cvt_pk_bf16(v[2], v[3]); w.z = cvt_pk_bf16(v[4], v[5]); w.w = cvt_pk_bf16(v[6], v[7]);
            *(u32x4*)(Wt + (size_t)n * K + k0) = w; }
    }
}
DI void phase_prologue(const Params& p, int gw, int nw, int lane) {
    unsigned char* sm = p.out;
    transpose_w(p.w_in, 1024, 3072, (bf16_t*)(sm + SM_WIN), 1, nullptr, nullptr, gw, nw, lane);
    transpose_w(p.w_out, 1024, 1024, (bf16_t*)(sm + SM_WOUT), 2, p.g_mix_a, p.g_mix_b, gw, nw, lane);
    transpose_w(p.w_xq, 1024, 1024, (bf16_t*)(sm + SM_WXQ), 4, p.ln1_g, nullptr, gw, nw, lane, 0.0625f);
    transpose_w(p.w_xkv, 1024, 2048, (bf16_t*)(sm + SM_WXKV), 0, nullptr, nullptr, gw, nw, lane);
    transpose_w(p.w_xo, 1024, 1024, (bf16_t*)(sm + SM_WXO), 0, nullptr, nullptr, gw, nw, lane);
    transpose_w(p.w_up, 1024, 4096, (bf16_t*)(sm + SM_WUP), 4, p.ln2_g, nullptr, gw, nw, lane, 1.f);
    transpose_w(p.w_down, 4096, 1024, (bf16_t*)(sm + SM_WDOWN), 0, nullptr, nullptr, gw, nw, lane);
    { float* cp = (float*)(sm + SM_CP); const int gt0 = gw * 64 + lane, nt0 = nw * 64;
      for (int e = gt0; e < 16 * 5120; e += nt0) { const int ks = e / 5120, col = e - ks * 5120; const bool xq = col < 1024;
          const float* W = xq ? p.w_xq + col : p.w_up + (col - 1024); const int N = xq ? 1024 : 4096; const float csc = xq ? 0.0625f : 1.f;
          const float* gv = xq ? p.ln1_g : p.ln2_g; const float* bv = xq ? p.ln1_b : p.ln2_b; float a1 = 0.f, a2 = 0.f;
#pragma unroll 8
          for (int k = ks * 64; k < ks * 64 + 64; ++k) { const float w = W[(size_t)k * N] * csc; float x = w; x *= gv[k]; a1 += bf_lo(cvt_pk_bf16(x, 0.f)); a2 += bv[k] * w; }
          cp[ks * 5120 + col] = a1; cp[(16 + ks) * 5120 + col] = a2; } }
    { float* ss = (float*)(sm + SM_SMALL); const int gt0 = gw * 64 + lane, nt0 = nw * 64;
      for (int i = gt0; i < SS_TOTAL; i += nt0) { float v = 0.f;
          if (i < 3720) v = p.rpb[i]; else if (i >= SS_LN1G && i < SS_LN1G + 1024) v = p.ln1_g[i - SS_LN1G]; else if (i >= SS_LN1B && i < SS_LN1B + 1024) v = p.ln1_b[i - SS_LN1B];
          else if (i >= SS_LN2G && i < SS_LN2G + 1024) v = p.ln2_g[i - SS_LN2G]; else if (i >= SS_LN2B && i < SS_LN2B + 1024) v = p.ln2_b[i - SS_LN2B];
          ss[i] = v; } }
    { bf16_t* mb = (bf16_t*)(sm + SM_MEMB); const int gt = gw * 64 + lane, nt = nw * 64;
      for (int i = gt; i < NMEM * 1024 / 8; i += nt) { const int e = i * 8; const float* s = e < 4096 * 1024 ? p.mem_prompt + e : p.mem_sample + (e - 4096 * 1024);
          const f32x4 a = *(const f32x4*)s, b = *(const f32x4*)(s + 4); u32x4 w; w.x = cvt_pk_bf16(a[0], a[1]); w.y = cvt_pk_bf16(a[2], a[3]); w.z = cvt_pk_bf16(b[0], b[1]); w.w = cvt_pk_bf16(b[2], b[3]);
          *(u32x4*)(mb + e) = w; }
      float* rc = (float*)(sm + SM_RC); float* rs = (float*)(sm + SM_RS);
      for (int i = gt; i < 8192 * 32; i += nt) { const int t = i >> 5, f = i & 31; const float inv = powf(10000.0f, -(float)f / 32.0f); const float ang = (float)t * inv;
          const double a = (double)ang; const double kq = rint(a * 0.15915494309189535); const float r = (float)(a - kq * 6.283185307179586);
          rc[i] = cosf(r); rs[i] = sinf(r); } }
    bf16_t* XN = (bf16_t*)(p.ws + WS_XN);
    f32x4 g[4], b[4];
    g[0] = *(const f32x4*)(p.ln_in_g + lane * 8); g[1] = *(const f32x4*)(p.ln_in_g + lane * 8 + 4); g[2] = *(const f32x4*)(p.ln_in_g + 512 + lane * 8); g[3] = *(const f32x4*)(p.ln_in_g + 516 + lane * 8);
    b[0] = *(const f32x4*)(p.ln_in_b + lane * 8); b[1] = *(const f32x4*)(p.ln_in_b + lane * 8 + 4); b[2] = *(const f32x4*)(p.ln_in_b + 512 + lane * 8); b[3] = *(const f32x4*)(p.ln_in_b + 516 + lane * 8);
#pragma unroll 1
    for (int row = gw; row < MTOK; row += 2 * nw) {
        const int row2 = row + nw;
        const float* x = row < MP ? p.x_prompt + (size_t)row * 1024 : p.x_sample + (size_t)(row - MP) * 1024;
        const float* y = row2 < MP ? p.x_prompt + (size_t)row2 * 1024 : p.x_sample + (size_t)(row2 - MP) * 1024;
        const f32x4 v0 = *(const f32x4*)(x + lane * 8), v1 = *(const f32x4*)(x + lane * 8 + 4), v2 = *(const f32x4*)(x + 512 + lane * 8), v3 = *(const f32x4*)(x + 516 + lane * 8);
        const f32x4 u0 = *(const f32x4*)(y + lane * 8), u1 = *(const f32x4*)(y + lane * 8 + 4), u2 = *(const f32x4*)(y + 512 + lane * 8), u3 = *(const f32x4*)(y + 516 + lane * 8);
        float s1 = hsum((v0 + v1) + (v2 + v3)), q1 = hsum((v0 * v0 + v1 * v1) + (v2 * v2 + v3 * v3)), s2 = hsum((u0 + u1) + (u2 + u3)), q2 = hsum((u0 * u0 + u1 * u1) + (u2 * u2 + u3 * u3));
        wave_sum4(s1, q1, s2, q2);
        const float m1 = s1 * (1.f / 1024.f), m2 = s2 * (1.f / 1024.f);
        const float r1 = rsqrtf(fmaxf(q1 * (1.f / 1024.f) - m1 * m1, 0.f) + LN_EPS_C), r2 = rsqrtf(fmaxf(q2 * (1.f / 1024.f) - m2 * m2, 0.f) + LN_EPS_C);
        ln_store<false>(v0, v1, v2, v3, m1, r1, g, b, XN, nullptr, row, lane);
        ln_store<false>(u0, u1, u2, u3, m2, r2, g, b, XN, nullptr, row2, lane);
    }
}

template <bool OUTF32>
DI void phase_ln(const bf16_t* __restrict__ Z, const float* __restrict__ gam, const float* __restrict__ bet, bf16_t* __restrict__ X, float* __restrict__ OF, int gw, int nw, int lane) {
    f32x4 g[4], b[4];
    g[0] = *(const f32x4*)(gam + lane * 8); g[1] = *(const f32x4*)(gam + lane * 8 + 4); g[2] = *(const f32x4*)(gam + 512 + lane * 8); g[3] = *(const f32x4*)(gam + 516 + lane * 8);
    b[0] = *(const f32x4*)(bet + lane * 8); b[1] = *(const f32x4*)(bet + lane * 8 + 4); b[2] = *(const f32x4*)(bet + 512 + lane * 8); b[3] = *(const f32x4*)(bet + 516 + lane * 8);
#pragma unroll 1
    for (int row = gw; row < MTOK; row += 2 * nw) {
        const int row2 = row + nw;
        const u32x4 za = *(const u32x4*)(Z + (size_t)row * 1024 + lane * 8), zb = *(const u32x4*)(Z + (size_t)row * 1024 + 512 + lane * 8);
        const u32x4 zc = *(const u32x4*)(Z + (size_t)row2 * 1024 + lane * 8), zd = *(const u32x4*)(Z + (size_t)row2 * 1024 + 512 + lane * 8);
        const f32x4 v0 = (f32x4){bf_lo(za.x), bf_hi(za.x), bf_lo(za.y), bf_hi(za.y)}, v1 = (f32x4){bf_lo(za.z), bf_hi(za.z), bf_lo(za.w), bf_hi(za.w)};
        const f32x4 v2 = (f32x4){bf_lo(zb.x), bf_hi(zb.x), bf_lo(zb.y), bf_hi(zb.y)}, v3 = (f32x4){bf_lo(zb.z), bf_hi(zb.z), bf_lo(zb.w), bf_hi(zb.w)};
        const f32x4 u0 = (f32x4){bf_lo(zc.x), bf_hi(zc.x), bf_lo(zc.y), bf_hi(zc.y)}, u1 = (f32x4){bf_lo(zc.z), bf_hi(zc.z), bf_lo(zc.w), bf_hi(zc.w)};
        const f32x4 u2 = (f32x4){bf_lo(zd.x), bf_hi(zd.x), bf_lo(zd.y), bf_hi(zd.y)}, u3 = (f32x4){bf_lo(zd.z), bf_hi(zd.z), bf_lo(zd.w), bf_hi(zd.w)};
        float s1 = hsum((v0 + v1) + (v2 + v3)), q1 = hsum((v0 * v0 + v1 * v1) + (v2 * v2 + v3 * v3)), s2 = hsum((u0 + u1) + (u2 + u3)), q2 = hsum((u0 * u0 + u1 * u1) + (u2 * u2 + u3 * u3));
        wave_sum4(s1, q1, s2, q2);
        const float m1 = s1 * (1.f / 1024.f), m2 = s2 * (1.f / 1024.f);
        const float r1 = rsqrtf(fmaxf(q1 * (1.f / 1024.f) - m1 * m1, 0.f) + LN_EPS_C), r2 = rsqrtf(fmaxf(q2 * (1.f / 1024.f) - m2 * m2, 0.f) + LN_EPS_C);
        ln_store<OUTF32>(v0, v1, v2, v3, m1, r1, g, b, X, OF, row, lane);
        ln_store<OUTF32>(u0, u1, u2, u3, m2, r2, g, b, X, OF, row2, lane);
    }
}

constexpr int VROW = 144;
constexpr int VWAVE = 64 * VROW;
constexpr int LDS_RMS = 8 * VWAVE;
constexpr int LDS_RPB = LDS_RMS + 1024;

DI void tr_read8(unsigned addr, s16x4 (&r)[8]) {
    asm volatile("s_waitcnt lgkmcnt(0)\n\t"
                 "ds_read_b64_tr_b16 %0, %8 offset:0\n\t" "ds_read_b64_tr_b16 %1, %8 offset:2304\n\t"
                 "ds_read_b64_tr_b16 %2, %8 offset:32\n\t" "ds_read_b64_tr_b16 %3, %8 offset:2336\n\t"
                 "ds_read_b64_tr_b16 %4, %8 offset:64\n\t" "ds_read_b64_tr_b16 %5, %8 offset:2368\n\t"
                 "ds_read_b64_tr_b16 %6, %8 offset:96\n\t" "ds_read_b64_tr_b16 %7, %8 offset:2400\n\t"
                 "s_waitcnt lgkmcnt(0)"
                 : "=&v"(r[0]), "=&v"(r[1]), "=&v"(r[2]), "=&v"(r[3]), "=&v"(r[4]), "=&v"(r[5]), "=&v"(r[6]), "=&v"(r[7]) : "v"(addr) : "memory");
}

template <int NO>
DI void softmax_chunk(f32x4 (&s)[4], float& m, float& l, f32x4 (&o)[NO], bf16x8 (&pf)[2]) {
    float mx = fmaxf(fmaxf(fmaxf(s[0][0], s[0][1]), fmaxf(s[0][2], s[0][3])), fmaxf(fmaxf(s[1][0], s[1][1]), fmaxf(s[1][2], s[1][3])));
    mx = fmaxf(mx, fmaxf(fmaxf(fmaxf(s[2][0], s[2][1]), fmaxf(s[2][2], s[2][3])), fmaxf(fmaxf(s[3][0], s[3][1]), fmaxf(s[3][2], s[3][3]))));
    if (__builtin_amdgcn_ballot_w64(mx > m + 16.f)) {
        mx = fmaxf(mx, __shfl_xor(mx, 16)); mx = fmaxf(mx, __shfl_xor(mx, 32));
        const float mn = fmaxf(m, mx), alpha = __builtin_amdgcn_exp2f((m - mn) * LOG2E_C); m = mn; l *= alpha;
#pragma unroll
        for (int c = 0; c < NO; ++c) o[c] *= alpha;
    }
    const float nb = -m * LOG2E_C;
    float ps = 0.f;
#pragma unroll
    for (int kt = 0; kt < 4; ++kt)
#pragma unroll
        for (int e = 0; e < 4; ++e) { const float pv = __builtin_amdgcn_exp2f(s[kt][e] * LOG2E_C + nb); s[kt][e] = pv; ps += pv; }
    l += ps;
#pragma unroll
    for (int pr = 0; pr < 2; ++pr) { u32x4 w; w.x = cvt_pk_bf16(s[2 * pr][0], s[2 * pr][1]); w.y = cvt_pk_bf16(s[2 * pr][2], s[2 * pr][3]);
        w.z = cvt_pk_bf16(s[2 * pr + 1][0], s[2 * pr + 1][1]); w.w = cvt_pk_bf16(s[2 * pr + 1][2], s[2 * pr + 1][3]); pf[pr] = __builtin_bit_cast(bf16x8, w); }
}

template <int NCH, class KOff, class VOff, class Score>
DI void attn64_run(const char* __restrict__ qkvb, const bf16x8 q0, const bf16x8 q1, unsigned char* vl, int lane, f32x4 (&o)[4], float& m, float& l, KOff koff, VOff voff, Score score) {
    const int fr = lane & 15, fq = lane >> 4;
    const unsigned vaddr = (unsigned)(size_t)vl + (unsigned)((4 * fq + (fr >> 2)) * VROW + (fr & 3) * 8);
    unsigned char* vw = vl + (lane >> 3) * VROW + (lane & 7) * 16;
    const unsigned char* krd = vl + fr * VROW + fq * 16;
    u32x4 kr[8], vr[8];
#pragma unroll
    for (int it = 0; it < 8; ++it) kr[it] = *(const u32x4*)(qkvb + koff(0, it));
#pragma unroll
    for (int it = 0; it < 8; ++it) vr[it] = *(const u32x4*)(qkvb + voff(0, it));
#pragma unroll 1
    for (int c = 0; c < NCH; ++c) {
        u32x4 vc[8];
#pragma unroll
        for (int it = 0; it < 8; ++it) *(u32x4*)(vw + it * 8 * VROW) = kr[it];
#pragma unroll
        for (int it = 0; it < 8; ++it) vc[it] = vr[it];
        __builtin_amdgcn_fence(__ATOMIC_RELEASE, "wavefront");
        bf16x8 kc[4][2];
#pragma unroll
        for (int kt = 0; kt < 4; ++kt) { kc[kt][0] = *(const bf16x8*)(krd + kt * 16 * VROW); kc[kt][1] = *(const bf16x8*)(krd + kt * 16 * VROW + 64); }
        if (c + 1 < NCH) {
#pragma unroll
            for (int it = 0; it < 8; ++it) kr[it] = *(const u32x4*)(qkvb + koff(c + 1, it));
#pragma unroll
            for (int it = 0; it < 8; ++it) vr[it] = *(const u32x4*)(qkvb + voff(c + 1, it));
        }
        f32x4 s[4];
#pragma unroll
        for (int kt = 0; kt < 4; ++kt) { s[kt] = __builtin_amdgcn_mfma_f32_16x16x32_bf16(kc[kt][0], q0, (f32x4){0.f, 0.f, 0.f, 0.f}, 0, 0, 0); s[kt] = __builtin_amdgcn_mfma_f32_16x16x32_bf16(kc[kt][1], q1, s[kt], 0, 0, 0); }
#pragma unroll
        for (int kt = 0; kt < 4; ++kt)
#pragma unroll
            for (int e = 0; e < 4; ++e) s[kt][e] = score(c, s[kt][e], kt, e);
        bf16x8 pf[2];
        softmax_chunk<4>(s, m, l, o, pf);
#pragma unroll
        for (int it = 0; it < 8; ++it) *(u32x4*)(vw + it * 8 * VROW) = vc[it];
#pragma unroll
        for (int pr = 0; pr < 2; ++pr) { s16x4 t[8]; tr_read8(vaddr + pr * 32 * VROW, t);
#pragma unroll
            for (int dc = 0; dc < 4; ++dc) { const bf16x8 vf = __builtin_shufflevector(t[2 * dc], t[2 * dc + 1], 0, 1, 2, 3, 4, 5, 6, 7); o[dc] = __builtin_amdgcn_mfma_f32_16x16x32_bf16(vf, pf[pr], o[dc], 0, 0, 0); } }
    }
}

template <int NO>
DI void softmax_pair(f32x4& s0, f32x4& s1, float& m, float& l, f32x4 (&o)[NO], bf16x8& pf) {
    float mx = fmaxf(fmaxf(fmaxf(s0[0], s0[1]), fmaxf(s0[2], s0[3])), fmaxf(fmaxf(s1[0], s1[1]), fmaxf(s1[2], s1[3])));
    if (__builtin_amdgcn_ballot_w64(mx > m + 16.f)) {
        mx = fmaxf(mx, __shfl_xor(mx, 16)); mx = fmaxf(mx, __shfl_xor(mx, 32));
        const float mn = fmaxf(m, mx), alpha = __builtin_amdgcn_exp2f((m - mn) * LOG2E_C); m = mn; l *= alpha;
#pragma unroll
        for (int c = 0; c < NO; ++c) o[c] *= alpha;
    }
    const float nb = -m * LOG2E_C;
    float ps = 0.f;
#pragma unroll
    for (int e = 0; e < 4; ++e) { s0[e] = __builtin_amdgcn_exp2f(s0[e] * LOG2E_C + nb); s1[e] = __builtin_amdgcn_exp2f(s1[e] * LOG2E_C + nb); ps += s0[e] + s1[e]; }
    l += ps;
    u32x4 w; w.x = cvt_pk_bf16(s0[0], s0[1]); w.y = cvt_pk_bf16(s0[2], s0[3]); w.z = cvt_pk_bf16(s1[0], s1[1]); w.w = cvt_pk_bf16(s1[2], s1[3]); pf = __builtin_bit_cast(bf16x8, w);
}
template <int NG, class KOff, class VOff, class Score, class Use, class Full>
DI void attn_mg_run(const int nimg, const char* __restrict__ qkvb, unsigned char* vl, int lane, f32x4 (&o)[NG][4], float (&m)[NG], float (&l)[NG], const bf16x8 (&q0)[NG], const bf16x8 (&q1)[NG],
                    KOff koff, VOff voff, Score score, Use use, Full full) {
    const int fr = lane & 15, fq = lane >> 4;
    const unsigned vaddr = (unsigned)(size_t)vl + (unsigned)(32 * VROW + (4 * fq + (fr >> 2)) * VROW + (fr & 3) * 8);
    unsigned char* vw = vl + (lane >> 3) * VROW + (lane & 7) * 16;
    const unsigned char* krd = vl + fr * VROW + fq * 16;
    u32x4 kr[4], vr[4];
#pragma unroll
    for (int j = 0; j < 4; ++j) { kr[j] = *(const u32x4*)(qkvb + koff(0, j)); vr[j] = *(const u32x4*)(qkvb + voff(0, j)); }
#pragma unroll 1
    for (int i = 0; i < nimg; ++i) {
#pragma unroll
        for (int j = 0; j < 4; ++j) { *(u32x4*)(vw + j * 8 * VROW) = kr[j]; *(u32x4*)(vw + (32 + j * 8) * VROW) = vr[j]; }
        __builtin_amdgcn_fence(__ATOMIC_RELEASE, "wavefront");
        bf16x8 kc[2][2];
#pragma unroll
        for (int kt = 0; kt < 2; ++kt) { kc[kt][0] = *(const bf16x8*)(krd + kt * 16 * VROW); kc[kt][1] = *(const bf16x8*)(krd + kt * 16 * VROW + 64); }
        if (i + 1 < nimg) {
#pragma unroll
            for (int j = 0; j < 4; ++j) { kr[j] = *(const u32x4*)(qkvb + koff(i + 1, j)); vr[j] = *(const u32x4*)(qkvb + voff(i + 1, j)); }
        }
        bf16x8 pf[NG];
#pragma unroll
        for (int g = 0; g < NG; ++g) {
            if (use(i, g)) {
                f32x4 s0 = __builtin_amdgcn_mfma_f32_16x16x32_bf16(kc[0][0], q0[g], (f32x4){0.f, 0.f, 0.f, 0.f}, 0, 0, 0); s0 = __builtin_amdgcn_mfma_f32_16x16x32_bf16(kc[0][1], q1[g], s0, 0, 0, 0);
                f32x4 s1 = __builtin_amdgcn_mfma_f32_16x16x32_bf16(kc[1][0], q0[g], (f32x4){0.f, 0.f, 0.f, 0.f}, 0, 0, 0); s1 = __builtin_amdgcn_mfma_f32_16x16x32_bf16(kc[1][1], q1[g], s1, 0, 0, 0);
                if (!full(i, g)) {
#pragma unroll
                    for (int e = 0; e < 4; ++e) { s0[e] = score(i, g, s0[e], 0, e); s1[e] = score(i, g, s1[e], 1, e); } }
                softmax_pair<4>(s0, s1, m[g], l[g], o[g], pf[g]);
            }
        }
        s16x4 t[8]; tr_read8(vaddr, t);
        bf16x8 vf[4];
#pragma unroll
        for (int dc = 0; dc < 4; ++dc) vf[dc] = __builtin_shufflevector(t[2 * dc], t[2 * dc + 1], 0, 1, 2, 3, 4, 5, 6, 7);
#pragma unroll
        for (int g = 0; g < NG; ++g) {
            if (use(i, g)) {
#pragma unroll
                for (int dc = 0; dc < 4; ++dc) o[g][dc] = __builtin_amdgcn_mfma_f32_16x16x32_bf16(vf[dc], pf[g], o[g][dc], 0, 0, 0);
            }
        }
    }
}

DI void attn64_finish(f32x4 (&o)[4], float l, float* rms, int& par, int wid, int lane, bf16_t* __restrict__ dst  ) {
    const int fr = lane & 15, fq = lane >> 4;
    l += __shfl_xor(l, 16); l += __shfl_xor(l, 32);
    const float inv = 1.0f / l; float ss = 0.f;
#pragma unroll
    for (int c = 0; c < 4; ++c) { o[c] *= inv; ss += (o[c][0] * o[c][0] + o[c][1] * o[c][1]) + (o[c][2] * o[c][2] + o[c][3] * o[c][3]); }
    ss += __shfl_xor(ss, 16); ss += __shfl_xor(ss, 32);
    float* rb = rms + par * 128;
    if (fq == 0) rb[wid * 16 + fr] = ss;
    __syncthreads();
    float tot = 0.f;
#pragma unroll
    for (int w = 0; w < 8; ++w) tot += rb[w * 16 + fr];
    const float rstd = rsqrtf(tot * (1.f / 512.f) + LN_EPS_C);
#pragma unroll
    for (int c = 0; c < 4; ++c) { u32x2 w; w.x = cvt_pk_bf16(o[c][0] * rstd, o[c][1] * rstd); w.y = cvt_pk_bf16(o[c][2] * rstd, o[c][3] * rstd); *(u32x2*)(dst + 16 * c + 4 * fq) = w; }
    par ^= 1;
}

DI void phase_attn(const Params& p, unsigned char* shm, int wid, int lane, int vcu) {
    const bf16_t* QKV = (const bf16_t*)(p.ws + WS_QKV); bf16_t* O = (bf16_t*)(p.out + OUT_O); const char* qkvb = (const char*)QKV;
    const int fr = lane & 15, fq = lane >> 4, h = wid, l3 = lane >> 3, l7 = lane & 7;
    unsigned char* vl = shm + wid * VWAVE; float* rms = (float*)(shm + LDS_RMS); float* rpbs = (float*)(shm + LDS_RPB);
    for (int i = threadIdx.x; i < 8 * 465 + 192; i += 512) rpbs[i] = (i >= 96 && i < 96 + 8 * 465) ? ((const float*)(p.out + SM_SMALL))[SS_RPB + i - 96] : 0.f;
    __syncthreads();
    int par = 0;
    float* ML = (float*)(p.out + SM_ML);
    for (int item = vcu; item < MTOK / 256; item += gridDim.x) {
        const int row_base = item * 256; const int T_ = row_base < MP ? 4096 : 8192; const int bb_ = row_base < MP ? (row_base & ~4095) : MP + ((row_base - MP) & ~8191); const int t0_ = row_base - bb_;
        const unsigned kcolb = (unsigned)(512 + h * 64) * 2u + 16u * l7, vcolb = (unsigned)(1024 + h * 64) * 2u + 16u * l7;
#pragma unroll 1
        for (int blk = 0; blk < (NO_P1 ? 0 : 4); ++blk) {
            int t0 = t0_, bb = bb_, T = T_; asm volatile("" : "+s"(t0), "+s"(bb), "+s"(T));
            const int tb = t0 + 64 * blk, kb = tb - 64;
            f32x4 o[4][4]; float m[4], l[4]; bf16x8 q0[4], q1[4];
#pragma unroll
            for (int g = 0; g < 4; ++g) { const bf16_t* qp = QKV + (size_t)(bb + tb + 16 * g + fr) * 3072 + h * 64 + 8 * fq; q0[g] = *(const bf16x8*)qp; q1[g] = *(const bf16x8*)(qp + 32); m[g] = -1e30f; l[g] = 0.f;
#pragma unroll
                for (int c = 0; c < 4; ++c) o[g][c] = (f32x4){0.f, 0.f, 0.f, 0.f}; }
            auto koff = [&](int i, int j) -> unsigned { int jj = kb + 32 * i + 8 * j + l3; jj = jj < 0 ? 0 : (jj > T - 1 ? T - 1 : jj); return (unsigned)(bb + jj) * 6144u + kcolb; };
            auto voff = [&](int i, int j) -> unsigned { int jj = kb + 32 * i + 8 * j + l3; jj = jj < 0 ? 0 : (jj > T - 1 ? T - 1 : jj); return (unsigned)(bb + jj) * 6144u + vcolb; };
            auto score = [&](int i, int g, float sv, int kt, int e) -> float { const int jq = tb + 16 * g + fr, lo = jq - 64 < 0 ? 0 : jq - 64, hi = jq + 64 > T - 1 ? T - 1 : jq + 64;
                const int base = kb + 32 * i + 4 * fq - lo; return ((unsigned)(base + 16 * kt + e) <= (unsigned)(hi - lo)) ? sv : -INFINITY; };
            auto use = [&](int i, int g) -> bool { return !((i == 5 && g < 2) || (i == 0 && g >= 2)); };
            auto full = [&](int i, int g) -> bool { return false; };
            attn_mg_run<4>(6, qkvb, vl, lane, o, m, l, q0, q1, koff, voff, score, use, full);
#pragma unroll
            for (int g = 0; g < 4; ++g) { float lt = l[g]; lt += __shfl_xor(lt, 16); lt += __shfl_xor(lt, 32);
                const size_t qrow = (size_t)(bb + tb + 16 * g + fr); const float inv = 1.0f / lt; bf16_t* dst = O + qrow * 1024 + h * 64 + 4 * fq;
#pragma unroll
                for (int c = 0; c < 4; ++c) { u32x2 w; w.x = cvt_pk_bf16(o[g][c][0] * inv, o[g][c][1] * inv); w.y = cvt_pk_bf16(o[g][c][2] * inv, o[g][c][3] * inv); *(u32x2*)(dst + 16 * c) = w; }
                if (fq == 0) { float2 ml; ml.x = m[g]; ml.y = lt; *(float2*)(ML + (qrow * 8 + h) * 2) = ml; } }
        }
    }
    __syncthreads();
    for (int item = vcu; item < MTOK / 256; item += gridDim.x) {
        const int row_base = item * 256; const int T_ = row_base < MP ? 4096 : 8192; const int bb_ = row_base < MP ? (row_base & ~4095) : MP + ((row_base - MP) & ~8191); const int t0_ = row_base - bb_;
        const unsigned kcolb = (unsigned)(512 + h * 64) * 2u + 16u * l7, vcolb = (unsigned)(1024 + h * 64) * 2u + 16u * l7;
#pragma unroll 1
        for (int r4 = 0; r4 < (NO_P2 ? 0 : 4); ++r4) { const int ah = 0;
            int t0 = t0_, bb = bb_, T = T_; asm volatile("" : "+s"(t0), "+s"(bb), "+s"(T));
            f32x4 o[4][4]; float m[4], l[4]; bf16x8 q0[4], q1[4];
#pragma unroll
            for (int a = 0; a < 4; ++a) { const size_t qrow = (size_t)(bb + t0 + r4 + 4 * (ah + a) + 16 * fr);
                const bf16_t* qp = QKV + qrow * 3072 + h * 64 + 8 * fq; q0[a] = *(const bf16x8*)qp; q1[a] = *(const bf16x8*)(qp + 32);
                const float2 ml = *(const float2*)(ML + (qrow * 8 + h) * 2); m[a] = ml.x; l[a] = fq == 0 ? ml.y : 0.f; const bf16_t* src = O + qrow * 1024 + h * 64 + 4 * fq;
#pragma unroll
                for (int c = 0; c < 4; ++c) { const u32x2 w = *(const u32x2*)(src + 16 * c); o[a][c] = (f32x4){bf_lo(w.x) * ml.y, bf_hi(w.x) * ml.y, bf_lo(w.y) * ml.y, bf_hi(w.y) * ml.y}; } }
            {
                const int L = T >> 2, kb = (t0 >> 2) - 64;
                auto koff = [&](int i, int j) -> unsigned { int jj = kb + 32 * i + 8 * j + l3; jj = jj < 0 ? 0 : (jj > L - 1 ? L - 1 : jj); return (unsigned)(bb + 4 * jj + r4) * 6144u + kcolb; };
                auto voff = [&](int i, int j) -> unsigned { int jj = kb + 32 * i + 8 * j + l3; jj = jj < 0 ? 0 : (jj > L - 1 ? L - 1 : jj); return (unsigned)(bb + 4 * jj + r4) * 6144u + vcolb; };
                auto score = [&](int i, int g, float sv, int kt, int e) -> float { const int jq = (t0 >> 2) + ah + g + 4 * fr, lo = jq - 64 < 0 ? 0 : jq - 64, hi = jq + 64 > L - 1 ? L - 1 : jq + 64;
                    const int base = kb + 32 * i + 4 * fq - lo; return ((unsigned)(base + 16 * kt + e) <= (unsigned)(hi - lo)) ? sv : -INFINITY; };
                auto use = [&](int i, int g) -> bool { return true; };
                auto full = [&](int i, int g) -> bool { return false; };
                attn_mg_run<4>(6, qkvb, vl, lane, o, m, l, q0, q1, koff, voff, score, use, full);
            }
#pragma unroll
            for (int a = 0; a < 4; ++a) {
                const int r = r4 + 4 * (ah + a), L = T >> 4, kb = (t0 >> 4) - 64;
                f32x4 (&o1)[1][4] = *reinterpret_cast<f32x4 (*)[1][4]>(&o[a]); float (&m1)[1] = *reinterpret_cast<float (*)[1]>(&m[a]); float (&l1)[1] = *reinterpret_cast<float (*)[1]>(&l[a]);
                const bf16x8 (&qa)[1] = *reinterpret_cast<const bf16x8 (*)[1]>(&q0[a]); const bf16x8 (&qb)[1] = *reinterpret_cast<const bf16x8 (*)[1]>(&q1[a]);
                auto koff = [&](int i, int j) -> unsigned { int jj = kb + 32 * i + 8 * j + l3; jj = jj < 0 ? 0 : (jj > L - 1 ? L - 1 : jj); return (unsigned)(bb + 16 * jj + r) * 6144u + kcolb; };
                auto voff = [&](int i, int j) -> unsigned { int jj = kb + 32 * i + 8 * j + l3; jj = jj < 0 ? 0 : (jj > L - 1 ? L - 1 : jj); return (unsigned)(bb + 16 * jj + r) * 6144u + vcolb; };
                auto score = [&](int i, int g, float sv, int kt, int e) -> float { const int jq = (t0 >> 4) + fr, lo = jq - 64 < 0 ? 0 : jq - 64, hi = jq + 64 > L - 1 ? L - 1 : jq + 64;
                    const int base = kb + 32 * i + 4 * fq - lo; return ((unsigned)(base + 16 * kt + e) <= (unsigned)(hi - lo)) ? sv : -INFINITY; };
                auto use = [&](int i, int g) -> bool { return true; };
                auto full = [&](int i, int g) -> bool { return false; };
                attn_mg_run<1>(5, qkvb, vl, lane, o1, m1, l1, qa, qb, koff, voff, score, use, full);
                attn64_finish(o1[0], l1[0], rms, par, wid, lane, O + (size_t)(bb + t0 + r + 16 * fr) * 1024 + h * 64);
            }
        }
    }
    for (int item = vcu; item < MTOK / 64; item += gridDim.x) {
        const int row_base = item * 64; const int T = row_base < MP ? 4096 : 8192; const int bb = row_base < MP ? (row_base & ~4095) : MP + ((row_base - MP) & ~8191);
        const int rows = T >> 6, rq = (row_base - bb) >> 6; int rs = rq - 4; rs = rs < 0 ? 0 : (rs > rows - 8 ? rows - 8 : rs);
        const unsigned kcolb = (unsigned)(2048 + h * 64) * 2u + 16u * l7, vcolb = (unsigned)(2560 + h * 64) * 2u + 16u * l7;
        f32x4 o[4][4]; float m[4], l[4]; bf16x8 q0[4], q1[4];
#pragma unroll
        for (int g = 0; g < 4; ++g) { const bf16_t* qp = QKV + (size_t)(row_base + 16 * g + fr) * 3072 + 1536 + h * 64 + 8 * fq; q0[g] = *(const bf16x8*)qp; q1[g] = *(const bf16x8*)(qp + 32); m[g] = -1e30f; l[g] = 0.f;
#pragma unroll
            for (int c = 0; c < 4; ++c) o[g][c] = (f32x4){0.f, 0.f, 0.f, 0.f}; }
        const unsigned kb0 = (unsigned)(bb + rs * 64 + l3) * 6144u;
        const float* bl = rpbs + 96 + h * 465 + 15 + (rs - rq + 7) * 31 + 4 * fq - fr;
        const int rsm = rs & 7;
        auto koff = [&](int i, int j) -> unsigned { const int a = ((i >> 1) + 8 - rsm) & 7; return kb0 + (unsigned)(a * 64 + 32 * (i & 1) + 8 * j) * 6144u + kcolb; };
        auto voff = [&](int i, int j) -> unsigned { const int a = ((i >> 1) + 8 - rsm) & 7; return kb0 + (unsigned)(a * 64 + 32 * (i & 1) + 8 * j) * 6144u + vcolb; };
        auto score = [&](int i, int g, float sv, int kt, int e) -> float { const int qc = 16 * g + fr; int cs = qc - 8; cs = cs < 0 ? 0 : (cs > 48 ? 48 : cs);
            const float bias = bl[(((i >> 1) + 8 - rsm) & 7) * 31 + 32 * (i & 1) + 16 * kt + e - 16 * g];
            return ((unsigned)(32 * (i & 1) + 4 * fq - cs + 16 * kt + e) < 16u) ? sv + bias : -INFINITY; };
        auto use = [&](int i, int g) -> bool { return (i & 1) ? (g > 0) : (g < 3); };
        auto full = [&](int i, int g) -> bool { return false; };
        attn_mg_run<4>(16, qkvb, vl, lane, o, m, l, q0, q1, koff, voff, score, use, full);
#pragma unroll
        for (int g = 0; g < 4; ++g) attn64_finish(o[g], l[g], rms, par, wid, lane, O + (size_t)(row_base + 16 * g + fr) * 1024 + 512 + h * 64);
    }
    __syncthreads();
}

constexpr int XK_PITCH = 528, XV_PITCH = 144, XK_BYTES = 64 * XK_PITCH, XV_BYTES = 256 * XV_PITCH;
DI void x_gload(const bf16_t* __restrict__ KM, const bf16_t* __restrict__ VTM, int bitem, int c, int tid, u32x4 (&r)[8]) {
    const int rb = bitem >> 2, h = bitem & 3, row0 = rb * 128; const int gb = row0 < MP ? (row0 >> 12) : 16 + ((row0 - MP) >> 13);
#pragma unroll
    for (int j = 0; j < 4; ++j) { const int q = tid + 512 * j; r[j] = *(const u32x4*)(KM + (size_t)(gb * 256 + 64 * c + (q >> 5)) * 1024 + h * 256 + (q & 31) * 8); }
#pragma unroll
    for (int j = 0; j < 4; ++j) { const int q = tid + 512 * j; r[4 + j] = *(const u32x4*)(VTM + (size_t)(h * 256 + (q >> 3)) * NMEM + gb * 256 + 64 * c + (q & 7) * 8); }
}
DI void x_lstore(unsigned char* kl, unsigned char* vl, int tid, const u32x4 (&r)[8]) {
#pragma unroll
    for (int j = 0; j < 4; ++j) { const int q = tid + 512 * j; *(u32x4*)(kl + (q >> 5) * XK_PITCH + (q & 31) * 16) = r[j]; }
#pragma unroll
    for (int j = 0; j < 4; ++j) { const int q = tid + 512 * j; *(u32x4*)(vl + (q >> 3) * XV_PITCH + (q & 7) * 16) = r[4 + j]; }
}
constexpr int XBUF = XK_BYTES + XV_BYTES;
DI void phase_xattn(const Params& p, unsigned char* shm, int wid, int lane) {
    const bf16_t* QX = (const bf16_t*)(p.ws + WS_QX); const bf16_t* KM = (const bf16_t*)(p.out + SM_KM); const bf16_t* VTM = (const bf16_t*)(p.out + SM_VTM); bf16_t* OC = (bf16_t*)(p.ws + WS_OC);
    const int fr = lane & 15, fq = lane >> 4, tid = threadIdx.x, G = gridDim.x;
    constexpr int NIT = (MTOK / 128) * 4;
    int bitem = blockIdx.x, step = 0;
    if (bitem < NIT) { u32x4 pre[8]; x_gload(KM, VTM, bitem, 0, tid, pre); x_lstore(shm, shm + XK_BYTES, tid, pre); }
    while (bitem < NIT) {
        const int rb = bitem >> 2, h = bitem & 3, row0 = rb * 128 + wid * 16;
        const bf16_t* qp = QX + (size_t)(row0 + fr) * 1024 + h * 256 + 8 * fq;
        bf16x8 qf[8];
#pragma unroll
        for (int ks = 0; ks < 8; ++ks) qf[ks] = *(const bf16x8*)(qp + 32 * ks);
        f32x4 o[16];
#pragma unroll
        for (int dc = 0; dc < 16; ++dc) o[dc] = (f32x4){0.f, 0.f, 0.f, 0.f};
        float m = -1e30f, l = 0.f;
#pragma unroll 1
        for (int c = 0; c < 4; ++c, ++step) {
            unsigned char* kl = shm + (step & 1) * XBUF; unsigned char* vl = kl + XK_BYTES;
            unsigned char* kn = shm + ((step & 1) ^ 1) * XBUF;
            const unsigned char* krd = kl + fr * XK_PITCH + fq * 16;
            const unsigned char* vrd = vl + fr * XV_PITCH + fq * 8;
            __syncthreads();
            const int nb = c < 3 ? bitem : bitem + G, nc = c < 3 ? c + 1 : 0; const bool has_next = nb < NIT;
            u32x4 pre[8];
            if (has_next) x_gload(KM, VTM, nb, nc, tid, pre);
            f32x4 s[4];
#pragma unroll
            for (int kt = 0; kt < 4; ++kt) { s[kt] = (f32x4){0.f, 0.f, 0.f, 0.f};
#pragma unroll
                for (int ks = 0; ks < 8; ++ks) { const bf16x8 kf = *(const bf16x8*)(krd + kt * 16 * XK_PITCH + ks * 64); s[kt] = __builtin_amdgcn_mfma_f32_16x16x32_bf16(kf, qf[ks], s[kt], 0, 0, 0); } }
            bf16x8 pf[2];
            softmax_chunk<16>(s, m, l, o, pf);
#pragma unroll
            for (int pr = 0; pr < 2; ++pr)
#pragma unroll
                for (int dc = 0; dc < 16; ++dc) { const unsigned char* vp = vrd + dc * 16 * XV_PITCH + pr * 64; const s16x4 lo = *(const s16x4*)vp, hi = *(const s16x4*)(vp + 32);
                    const bf16x8 vf = __builtin_shufflevector(lo, hi, 0, 1, 2, 3, 4, 5, 6, 7); o[dc] = __builtin_amdgcn_mfma_f32_16x16x32_bf16(vf, pf[pr], o[dc], 0, 0, 0); }
            if (has_next) x_lstore(kn, kn + XK_BYTES, tid, pre);
        }
        l += __shfl_xor(l, 16); l += __shfl_xor(l, 32);
        const float inv = 1.0f / l; bf16_t* dst = OC + (size_t)(row0 + fr) * 1024 + h * 256 + 4 * fq;
#pragma unroll
        for (int dc = 0; dc < 16; ++dc) { u32x2 w; w.x = cvt_pk_bf16(o[dc][0] * inv, o[dc][1] * inv); w.y = cvt_pk_bf16(o[dc][2] * inv, o[dc][3] * inv); *(u32x2*)(dst + 16 * dc) = w; }
        bitem += G;
    }
    __syncthreads();
}

#define XB_TMO      128
#define XB_XCNT(j)  (256  + 64 * (j))
#define XB_XSUB(j)  (1280 + 64 * (j))
#define XB_XGEN(j)  (2304 + 64 * (j))
#define XB_TOP      3328
#define XB_TOPGEN   3392
#define XCD_BAR_WORDS 3456
#define XB_SPIN_CAP (1u << 18)
__device__ __forceinline__ unsigned xb_ld(unsigned* p)              { return __hip_atomic_load(p, __ATOMIC_RELAXED, __HIP_MEMORY_SCOPE_AGENT); }
__device__ __forceinline__ unsigned xb_add(unsigned* p, unsigned v) { return __hip_atomic_fetch_add(p, v, __ATOMIC_RELAXED, __HIP_MEMORY_SCOPE_AGENT); }
__device__ __forceinline__ unsigned xb_xcc_id() { return (unsigned)__builtin_amdgcn_s_getreg((3 << 11) | 20) & 0xFu; }
#define XB_SPIN(cond, bar) do { unsigned _sp = 0; while (cond) { __builtin_amdgcn_s_sleep(1); \
    if ((++_sp & 255u) == 0u) { if (xb_ld(&(bar)[XB_TMO])) break; if (_sp > XB_SPIN_CAP) { atomicAdd(&(bar)[XB_TMO], 1u); break; } } } } while (0)
struct XcdBarrier { unsigned* bar; unsigned x; volatile PG8_LAS unsigned* st; };
__device__ __forceinline__ XcdBarrier xcd_barrier_post(unsigned* bar, volatile PG8_LAS unsigned* st) {
    XcdBarrier b; b.bar = bar; b.x = xb_xcc_id(); b.st = st;
    if (threadIdx.x == 0) (void)xb_add(&bar[XB_XCNT(b.x)], 1u);
    return b;
}
__device__ __forceinline__ void xcd_barrier_complete(unsigned* bar, unsigned x, unsigned& nloc, unsigned& nx) {
    const unsigned G = gridDim.x * gridDim.y * gridDim.z;
    unsigned sum, cnt, mine, sp = 0u;
    for (;;) {
        sum = 0u; cnt = 0u; mine = 0u;
#pragma unroll
        for (unsigned j = 0; j < 16; ++j) { const unsigned c = xb_ld(&bar[XB_XCNT(j)]); sum += c; cnt += (c > 0u) ? 1u : 0u; mine = (j == x) ? c : mine; }
        if (sum == G) break;
        __builtin_amdgcn_s_sleep(1);
        if ((++sp & 255u) == 0u) { if (xb_ld(&bar[XB_TMO])) break; if (sp > XB_SPIN_CAP) { atomicAdd(&bar[XB_TMO], 1u); break; } }
    }
    nloc = mine > 0u ? mine : 1u; nx = cnt > 0u ? cnt : 1u;
}
__device__ __forceinline__ void xcd_barrier(unsigned* bar_, volatile PG8_LAS unsigned* st_) {
    XcdBarrier b; b.bar = bar_; b.st = st_; b.x = 0u;
    asm volatile("s_waitcnt vmcnt(0)" ::: "memory");
    __syncthreads();
    if (threadIdx.x == 0) {
        unsigned* bar = b.bar; b.x = xb_xcc_id();
        __builtin_amdgcn_s_waitcnt(0);
        unsigned nloc = b.st[0], nx = b.st[1];
        if (nloc == 0u) { xcd_barrier_complete(bar, b.x, nloc, nx); b.st[0] = nloc; b.st[1] = nx; }
        const unsigned old = xb_add(&bar[XB_XSUB(b.x)], 1u);
        const unsigned gen = old / nloc;
        if (old + 1u == (gen + 1u) * nloc) {
            __builtin_amdgcn_fence(__ATOMIC_RELEASE, "agent");
            asm volatile("s_waitcnt vmcnt(0)" ::: "memory");
            const unsigned og = xb_add(&bar[XB_TOP], 1u);
            const unsigned tg = og / nx;
            if (og + 1u == (tg + 1u) * nx) xb_add(&bar[XB_TOPGEN], 1u);
            else XB_SPIN(xb_ld(&bar[XB_TOPGEN]) == tg, bar);
            __builtin_amdgcn_fence(__ATOMIC_ACQUIRE, "agent");
            xb_add(&bar[XB_XGEN(b.x)], 1u);
            asm volatile("s_waitcnt vmcnt(0)" ::: "memory");
        } else {
            XB_SPIN(xb_ld(&bar[XB_XGEN(b.x)]) == gen, bar);
            __builtin_amdgcn_fence(__ATOMIC_ACQUIRE, "agent");
            asm volatile("s_waitcnt vmcnt(0)" ::: "memory");
        }
    }
    __syncthreads();
}

constexpr int LDS_XB = 2 * (64 * 528 + 256 * 144);
constexpr int LDS_BYTES = LDS_XB + 64;
constexpr int NPHASE = 14;

__global__ void __launch_bounds__(512, 2) fwd_megakernel(const Params p) {
    extern __shared__ __attribute__((aligned(16))) unsigned char shm[];
    PG8_LAS unsigned char* lds = (PG8_LAS unsigned char*)shm;
    const int tid = threadIdx.x, wid = __builtin_amdgcn_readfirstlane(tid >> 6), lane = tid & 63;
    const int G = gridDim.x, gw = blockIdx.x * 8 + wid, nw = G * 8;
    unsigned char* ws = p.ws; unsigned char* sm = p.out;
    const int lo = p.ph_lo, hi = p.ph_hi;
    volatile PG8_LAS unsigned* xbst = (volatile PG8_LAS unsigned*)(lds + LDS_XB);
    if (tid < 16) xbst[tid] = 0u;
    __syncthreads();
    if (tid == 0) { const unsigned x = xb_xcc_id(); const unsigned idx = xb_add((unsigned*)(sm + SM_BAR) + XB_XCNT(x), 1u); xbst[2] = x; xbst[3] = idx; xbst[4] = blockIdx.x; xbst[5] = blockIdx.x; }
    __syncthreads();
#ifdef PROBE_TS
    unsigned long long ts[15]; ts[0] = __builtin_amdgcn_s_memrealtime();
#define STAMP(k) ts[(k) + 1] = __builtin_amdgcn_s_memrealtime()
#else
#define STAMP(k)
#endif
#define IN(k) (((PH_MASK >> (k)) & 1) && lo <= (k) && (k) < hi)
#define SEAM(k) do { if ((k) + 1 < hi) { if (lo < 0) { __threadfence(); cg::this_grid().sync(); }     \
        xcd_barrier((k) == 12 ? (unsigned*)(p.ws + WS_BAR2) : (unsigned*)(p.out + SM_BAR), (volatile PG8_LAS unsigned*)((PG8_LAS unsigned char*)shm + LDS_XB)); } STAMP(k); } while (0)
    if (IN(0)) { phase_prologue(p, gw, nw, lane); } if (lo <= 0 && 0 < hi) SEAM(0);
    if (lo <= 0 && 0 < hi) {
        if (tid == 0) { unsigned* bar = (unsigned*)(sm + SM_BAR); bool ok = (G % 8) == 0; unsigned pop = 0;
            for (unsigned j = 0; j < 16; ++j) { const unsigned c = xb_ld(&bar[XB_XCNT(j)]); if (c != 0u) { ++pop; if (c != (unsigned)G / 8u) ok = false; } }
            ok = ok && pop == 8u && xbst[2] < 8u;
            if (ok) { xbst[4] = xbst[2] * ((unsigned)G / 8u) + xbst[3];
                      xbst[5] = xbst[3] * 8u + xbst[2]; } }
        __syncthreads();
    }
    const int vcu = __builtin_amdgcn_readfirstlane((int)xbst[4]), cid = __builtin_amdgcn_readfirstlane((int)xbst[5]);
    if (IN(1)) {
        { const float* cp = (const float*)(sm + SM_CP); float* cv = (float*)(sm + SM_CV); const int gt0 = gw * 64 + lane;
          if (gt0 < 5120) { float a1 = 0.f, a2 = 0.f;
#pragma unroll
              for (int ks = 0; ks < 16; ++ks) { a1 += cp[ks * 5120 + gt0]; a2 += cp[(16 + ks) * 5120 + gt0]; }
              cv[gt0] = a1; cv[5120 + gt0] = a2; } }
        { pg8::StaticOrder S; pg8::Gemm g{(const bf16_t*)(ws + WS_XN), (const bf16_t*)(sm + SM_WIN), MTOK, 3072, 1024}; S.init(g.M, g.N, G, cid);
          EpiQKV E{(bf16_t*)(ws + WS_QKV), (const float*)(sm + SM_RC), (const float*)(sm + SM_RS)}; pg8::gemm_phase(lds, g, S, E); }
#if !defined(NO_KV)
        { pg8::StaticOrder S; pg8::Gemm g{(const bf16_t*)(sm + SM_MEMB), (const bf16_t*)(sm + SM_WXKV), NMEM, 1024, 1024}; S.init(g.M, g.N, G, cid);
          EpiPlain E{(bf16_t*)(sm + SM_KM), 1024}; pg8::gemm_phase(lds, g, S, E); }
        { pg8::StaticOrder S; pg8::Gemm g{(const bf16_t*)(sm + SM_WXKV) + (size_t)1024 * 1024, (const bf16_t*)(sm + SM_MEMB), 1024, NMEM, 1024}; S.init(g.M, g.N, G, (cid + 128) % G);
          EpiPlain E{(bf16_t*)(sm + SM_VTM), NMEM}; pg8::gemm_phase(lds, g, S, E); }
#endif
    } if (lo <= 1 && 1 < hi) SEAM(1);
    if (IN(2)) { phase_attn(p, shm, wid, lane, vcu);
#ifdef DUP_ATTN
        __syncthreads(); phase_attn(p, shm, wid, lane, vcu);
#endif
    } if (lo <= 2 && 2 < hi) SEAM(2);
    if (IN(3)) { pg8::StaticOrder S; pg8::Gemm g{(const bf16_t*)(sm + OUT_O), (const bf16_t*)(sm + SM_WOUT), MTOK, 1024, 1024}; S.init(g.M, g.N, G, cid);
        EpiGen<0, 1, 1, 0> E{(bf16_t*)(ws + WS_Z1), 1024, nullptr, nullptr, nullptr, (const bf16_t*)(ws + WS_XN), nullptr, nullptr, nullptr, (float*)(sm + SM_S1)}; pg8::gemm_phase(lds, g, S, E); } if (lo <= 3 && 3 < hi) SEAM(3);
    if (IN(5)) { pg8::StaticOrder S; pg8::Gemm g{(const bf16_t*)(ws + WS_Z1), (const bf16_t*)(sm + SM_WXQ), MTOK, 1024, 1024}; S.init(g.M, g.N, G, cid);
        EpiGen<1, 0, 0, 0> E{(bf16_t*)(ws + WS_QX), 1024, (const float*)(sm + SM_S1), (const float*)(sm + SM_CV), (const float*)(sm + SM_CV) + 5120, nullptr, nullptr, nullptr, nullptr, nullptr}; pg8::gemm_phase(lds, g, S, E); } if (lo <= 5 && 5 < hi) SEAM(5);
    if (IN(6)) { phase_xattn(p, shm, wid, lane); } if (lo <= 6 && 6 < hi) SEAM(6);
    if (IN(7)) { pg8::StaticOrder S; pg8::Gemm g{(const bf16_t*)(ws + WS_OC), (const bf16_t*)(sm + SM_WXO), MTOK, 1024, 1024}; S.init(g.M, g.N, G, cid);
        EpiGen<0, 2, 1, 0> E{(bf16_t*)(ws + WS_X2), 1024, nullptr, nullptr, nullptr, (const bf16_t*)(ws + WS_Z1), (const float*)(sm + SM_S1), (const float*)(sm + SM_SMALL) + SS_LN1G, (const float*)(sm + SM_SMALL) + SS_LN1B, (float*)(sm + SM_S2)};
        pg8::gemm_phase(lds, g, S, E); } if (lo <= 7 && 7 < hi) SEAM(7);
#define UPDOWN(ch) do { const size_t r0 = (size_t)(ch) * MP; \
        if (IN(9 + 2 * (ch))) { pg8::StaticOrder S; pg8::Gemm g{(const bf16_t*)(ws + WS_X2) + r0 * 1024, (const bf16_t*)(sm + SM_WUP), MP, 4096, 1024}; S.init(g.M, g.N, G, cid); \
            EpiGen<1, 0, 0, 1> E{(bf16_t*)(ws + WS_H), 4096, (const float*)(sm + SM_S2) + r0 * 2, (const float*)(sm + SM_CV) + 1024, (const float*)(sm + SM_CV) + 5120 + 1024, nullptr, nullptr, nullptr, nullptr, nullptr}; pg8::gemm_phase(lds, g, S, E); } if (lo <= 9 + 2 * (ch) && 9 + 2 * (ch) < hi) SEAM(9 + 2 * (ch)); \
        if (IN(10 + 2 * (ch))) { pg8::StaticOrder S; pg8::Gemm g{(const bf16_t*)(ws + WS_H), (const bf16_t*)(sm + SM_WDOWN), MP, 1024, 4096}; S.init(g.M, g.N, G, cid); \
            EpiGen<0, 2, 0, 0> E{(bf16_t*)(ws + WS_Z3) + r0 * 1024, 1024, nullptr, nullptr, nullptr, (const bf16_t*)(ws + WS_X2) + r0 * 1024, (const float*)(sm + SM_S2) + r0 * 2, (const float*)(sm + SM_SMALL) + SS_LN2G, (const float*)(sm + SM_SMALL) + SS_LN2B, nullptr}; pg8::gemm_phase(lds, g, S, E); } if (lo <= 10 + 2 * (ch) && 10 + 2 * (ch) < hi) SEAM(10 + 2 * (ch)); } while (0)
    UPDOWN(0);
    if (lo <= 11 && 11 < hi && blockIdx.x == 0) { for (int i = tid; i < XCD_BAR_WORDS; i += 512) ((unsigned*)(ws + WS_BAR2))[i] = 0u; }
    UPDOWN(1);
#ifdef PROBE_TS
    { const float tot = (float)(ts[13] - ts[0]); const float fa = (float)(ts[PROBE_A1 + 1] - ts[PROBE_A0]) / tot, fb = (float)(ts[PROBE_B1 + 1] - ts[PROBE_B0]) / tot;
      const float fa_q = floorf(fa * 32.f + 0.5f) * (1.f / 32.f), fb_q = floorf(fb * 32.f + 0.5f) * (1.f / 32.f);
      if (IN(13)) { phase_ln<true>((const bf16_t*)(ws + WS_Z3), p.ln3_g, p.ln3_b, nullptr, (float*)p.out, gw, nw, lane, 1.f + fa_q, 1000.f * fb_q); } }
#else
    if (IN(13)) { phase_ln<true>((const bf16_t*)(ws + WS_Z3), p.ln3_g, p.ln3_b, nullptr, (float*)p.out, gw, nw, lane); }
#endif
}

extern "C" void kernel_launch(void* const* d_in, const int* in_sizes, int n_in, void* d_out, int out_size, void* d_ws, size_t ws_size, hipStream_t stream) {
    static int grid = 0;
    if (grid == 0) {
        if (n_in != 22 || ws_size < WS_NEED || (size_t)out_size != (size_t)MTOK * 1024) { fprintf(stderr, "kernel_launch: unexpected shapes (n_in %d, ws %zu, out %d); nothing launched\n", n_in, ws_size, out_size); grid = -1; return; }
        int dev = 0, cus = 0, per_cu = 0;
        hipGetDevice(&dev); hipDeviceGetAttribute(&cus, hipDeviceAttributeMultiprocessorCount, dev);
        if (hipFuncSetAttribute((const void*)fwd_megakernel, hipFuncAttributeMaxDynamicSharedMemorySize, LDS_BYTES) != hipSuccess) { fprintf(stderr, "kernel_launch: hipFuncSetAttribute failed\n"); grid = -1; return; }
        if (hipOccupancyMaxActiveBlocksPerMultiprocessor(&per_cu, (const void*)fwd_megakernel, 512, LDS_BYTES) != hipSuccess || per_cu < 1) { fprintf(stderr, "kernel_launch: occupancy query says %d\n", per_cu); per_cu = 1; }
        (void)hipGetLastError();
        grid = cus * 1;
    }
    if (grid < 0) return;
    Params p{};
    const float** pp = (const float**)&p;
    for (int i = 0; i < 22; ++i) pp[i] = (const float*)d_in[i];
    p.out = (unsigned char*)d_out; p.ws = (unsigned char*)d_ws;
    if (hipMemsetAsync((unsigned char*)d_out + SM_BAR, 0, 65536 + 2 * MiB, stream) != hipSuccess) { fprintf(stderr, "kernel_launch: hipMemsetAsync of the barrier words failed\n"); return; }
#if N_LAUNCHES == 1
    p.ph_lo = 0; p.ph_hi = NPHASE;
    void* args[] = {(void*)&p};
    hipError_t e = hipLaunchCooperativeKernel((const void*)fwd_megakernel, dim3(grid), dim3(512), args, LDS_BYTES, stream);
    if (e != hipSuccess) fprintf(stderr, "cooperative launch failed: %s (grid %d)\n", hipGetErrorString(e), grid);
#else
    for (int ph = 0; ph < NPHASE; ++ph) { p.ph_lo = ph; p.ph_hi = ph + 1; hipLaunchKernelGGL(fwd_megakernel, dim3(grid), dim3(512), LDS_BYTES, stream, p); }
#endif
}
```

```cpp
#include <hip/hip_runtime.h>
#include <hip/hip_cooperative_groups.h>
#include <cstdio>
namespace cg = cooperative_groups;

#define DI __device__ __forceinline__
#define PG8_LAS __attribute__((address_space(3)))
typedef unsigned short bf16_t;
typedef short bf16x8 __attribute__((ext_vector_type(8)));
typedef short s16x4 __attribute__((ext_vector_type(4)));
typedef float f32x4 __attribute__((ext_vector_type(4)));
typedef unsigned u32x4 __attribute__((ext_vector_type(4)));
typedef unsigned u32x2 __attribute__((ext_vector_type(2)));

#ifndef NO_P1
#define NO_P1 0
#endif
#ifndef NO_P2
#define NO_P2 0
#endif
#ifndef PH_MASK
#define PH_MASK 0xffff
#endif
#ifndef N_LAUNCHES
#define N_LAUNCHES 1
#endif

constexpr int MTOK = 131072, MP = 65536, NMEM = 6144;
constexpr float ALPHA_C = 1.189207115002721f, LN_EPS_C = 1e-5f, LOG2E_C = 1.4426950408889634f;
constexpr size_t MiB = (size_t)1 << 20;
constexpr size_t WS_XN = 0, WS_QKV = 256 * MiB, WS_Z1 = 256 * MiB, WS_QX = 512 * MiB, WS_OC = 768 * MiB, WS_X1 = 0, WS_Z2 = 256 * MiB, WS_X2 = 512 * MiB, WS_H = 0, WS_Z3 = 768 * MiB;
constexpr size_t WS_NEED = 1024 * MiB;
constexpr size_t WS_BAR2 = 512 * MiB;
constexpr size_t OUT_O = 0, OUT_SM = 256 * MiB;
constexpr size_t SM_WIN = OUT_SM, SM_WOUT = SM_WIN + 6 * MiB, SM_WXQ = SM_WOUT + 2 * MiB, SM_WXKV = SM_WXQ + 2 * MiB, SM_WXO = SM_WXKV + 4 * MiB, SM_WUP = SM_WXO + 2 * MiB,
                 SM_WDOWN = SM_WUP + 8 * MiB, SM_MEMB = SM_WDOWN + 8 * MiB, SM_KM = SM_MEMB + 12 * MiB, SM_VTM = SM_KM + 12 * MiB, SM_RC = SM_VTM + 12 * MiB, SM_RS = SM_RC + 1 * MiB, SM_ML = SM_RS + 1 * MiB  , SM_BAR = SM_ML + 8 * MiB  , SM_S1 = SM_BAR + 65536  , SM_S2 = SM_S1 + 1 * MiB  ,
                 SM_SMALL = SM_S2 + 1 * MiB  ,
                 SM_CV = SM_SMALL + 65536  , SM_CP = SM_CV + 65536  ;
constexpr int SS_RPB = 0, SS_LN1G = 4096, SS_LN1B = 5120, SS_LN2G = 6144, SS_LN2B = 7168, SS_TOTAL = 8192;

struct Params {
    const float *x_prompt, *x_sample, *mem_prompt, *mem_sample, *ln_in_g, *ln_in_b, *w_in, *rpb, *g_mix_a, *g_mix_b, *w_out, *ln1_g, *ln1_b, *w_xq, *w_xkv, *w_xo, *ln2_g, *ln2_b, *w_up, *w_down, *ln3_g, *ln3_b;
    unsigned char* out; unsigned char* ws; int ph_lo, ph_hi;
};

typedef __bf16 bf16x2n __attribute__((ext_vector_type(2)));
typedef float f32x2n __attribute__((ext_vector_type(2)));
DI unsigned cvt_pk_bf16(float lo, float hi) { const f32x2n v = {lo, hi}; const bf16x2n b = __builtin_convertvector(v, bf16x2n); return __builtin_bit_cast(unsigned, b); }
DI float bf_lo(unsigned w) { return __uint_as_float(w << 16); }
DI float bf_hi(unsigned w) { return __uint_as_float(w & 0xffff0000u); }
DI float wave_sum(float v) { for (int o = 32; o >= 1; o >>= 1) v += __shfl_xor(v, o); return v; }

namespace pg8 {
constexpr int BM = 256, BK = 64, HALF = 128, HTB = HALF * BK * 2, STAGE_BYTES = 8 * HTB, NXCD = 8, WGM = 8;
__host__ __device__ __forceinline__ int lds_byte(int r, int c) { const int st = (r >> 4) * 2 + (c >> 5), rr = r & 15, cc = c & 31, ob = rr * 64 + cc * 2; return st * 1024 + (ob ^ (((ob >> 9) & 1) << 5)); }
__host__ __device__ __forceinline__ void stage_rc(int b, int& R, int& C) { const int st = b / 1024, sb = b % 1024, swz = sb ^ (((sb >> 9) & 1) << 5); R = (st >> 1) * 16 + swz / 64; C = (st & 1) * 32 + (swz % 64) / 2; }
__host__ __device__ __forceinline__ int perm32(int rho) { const int n = rho >> 4, i = rho & 15; return 8 * (i >> 2) + 4 * n + (i & 3); }
struct Unit { int pm, pn; };
struct Gemm { const bf16_t* A; const bf16_t* Bt; int M, N, K; };
struct StaticOrder {
    int nM, nN, nwg, G, c;
    __device__ void init(int M, int N, int G_, int c_) { nM = M / BM; nN = N / BM; nwg = nM * nN; G = G_; c = c_; }
    __device__ bool next(int i, Unit& u) const {
        const long L = (long)i * G + c; if (L >= nwg) return false;
        int wgid = (int)L; { const int q = nwg / NXCD, r = nwg % NXCD, xcd = wgid % NXCD, off = wgid / NXCD; wgid = (xcd < r ? xcd * (q + 1) : r * (q + 1) + (xcd - r) * q) + off; }
        const int nig = WGM * nN, gid = wgid / nig, fm = gid * WGM, gsz = (nM - fm) < WGM ? (nM - fm) : WGM;
        u.pm = fm + ((wgid % nig) % gsz); u.pn = (wgid % nig) / gsz; return true;
    }
};

template <class Epi, bool ALIGN_EPI = true, bool SP2 = true>
__device__ __forceinline__ void gemm_phase(PG8_LAS unsigned char* lds, const Gemm g, const StaticOrder& S, const Epi& E) {
    const int tid = threadIdx.x, wid = __builtin_amdgcn_readfirstlane(tid >> 6), lane = tid & 63, wr = wid >> 2, wc = wid & 3, fr = lane & 15, fq = lane >> 4;
    const int K = g.K, nt = K / BK;
    unsigned voffA[2], voffB[2];
#pragma unroll
    for (int i = 0; i < 2; ++i) { int R, C; stage_rc(tid * 16 + i * 8192, R, C); const int Rb = Epi::PERM ? ((R & ~31) + perm32(R & 31)) : R;
        voffA[i] = (unsigned)(R * K + C) * 2u; voffB[i] = (unsigned)(Rb * K + C) * 2u; }
    const size_t kstep = (size_t)(BK * 2);
    const size_t hstep = (size_t)HALF * K * 2;
    const size_t tstep = 2 * hstep;
    const unsigned ldsw = (unsigned)wid * 1024u;
    const int aoff = lds_byte(wr * 64 + fr, fq * 8), boff = lds_byte(wc * 32 + fr, fq * 8);
#define PG8_SA(b, h) (((b) * 2 + (h)) * HTB)
#define PG8_SB(b, h) ((4 + (b) * 2 + (h)) * HTB)
#define PG8_STAGE(bufoff, gbase, voff) do { _Pragma("unroll") for (int _i = 0; _i < 2; ++_i) \
        __builtin_amdgcn_global_load_lds((const unsigned*)((const char*)(gbase) + (voff)[_i]), (PG8_LAS unsigned*)(lds + (bufoff) + ldsw + _i * 8192), 16, 0, 0); } while (0)
#define PG8_LDA(dst, b, h) do { _Pragma("unroll") for (int m = 0; m < 4; ++m) _Pragma("unroll") for (int k = 0; k < 2; ++k) dst[m][k] = *(const PG8_LAS bf16x8*)(lds + PG8_SA(b, h) + aoff + m * 2048 + k * 1024); } while (0)
#define PG8_LDB(dst, b, h) do { _Pragma("unroll") for (int n = 0; n < 2; ++n) _Pragma("unroll") for (int k = 0; k < 2; ++k) dst[n][k] = *(const PG8_LAS bf16x8*)(lds + PG8_SB(b, h) + boff + n * 2048 + k * 1024); } while (0)
#define PG8_MMA(ai, bj, At, Bt) do { __builtin_amdgcn_s_setprio(1); _Pragma("unroll") for (int m = 0; m < 4; ++m) _Pragma("unroll") for (int n = 0; n < 2; ++n) _Pragma("unroll") for (int k = 0; k < 2; ++k) \
        acc[ai][bj][m][n] = __builtin_amdgcn_mfma_f32_16x16x32_bf16(Bt[n][k], At[m][k], acc[ai][bj][m][n], 0, 0, 0); __builtin_amdgcn_s_setprio(0); } while (0)
#define PG8_WAIT_V(n) asm volatile("s_waitcnt vmcnt(" #n ")" ::: "memory")
#define PG8_WAIT_L(n) asm volatile("s_waitcnt lgkmcnt(" #n ")" ::: "memory")
#define PG8_BAR __builtin_amdgcn_s_barrier()
#define PG8_SCHED __builtin_amdgcn_sched_barrier(0)
    Unit cur, nxt; int ui = 0;
    if (!S.next(0, cur)) return;
    f32x4 acc[2][2][4][2];
#pragma unroll
    for (int a = 0; a < 2; ++a)
#pragma unroll
        for (int b = 0; b < 2; ++b)
#pragma unroll
            for (int m = 0; m < 4; ++m)
#pragma unroll
                for (int n = 0; n < 2; ++n) acc[a][b][m][n] = (f32x4){0.f, 0.f, 0.f, 0.f};
    bf16x8 At[4][2], B0[2][2], B1[2][2];
    const char* cA = (const char*)g.A + (size_t)cur.pm * tstep; const char* cB = (const char*)g.Bt + (size_t)cur.pn * tstep;
    if constexpr (SP2) {
        PG8_STAGE(PG8_SB(0, 0), cB, voffB); PG8_STAGE(PG8_SB(0, 1), cB + hstep, voffB); PG8_STAGE(PG8_SA(0, 0), cA, voffA); PG8_STAGE(PG8_SA(0, 1), cA + hstep, voffA);
        if (wr == 1) PG8_BAR;
        PG8_WAIT_V(2); PG8_BAR;
        PG8_STAGE(PG8_SB(1, 0), cB + kstep, voffB); PG8_STAGE(PG8_SA(1, 0), cA + kstep, voffA); PG8_STAGE(PG8_SB(1, 1), cB + hstep + kstep, voffB);
        PG8_WAIT_V(6); PG8_BAR;
    } else {
    PG8_STAGE(PG8_SB(0, 0), cB, voffB); PG8_STAGE(PG8_SA(0, 0), cA, voffA); PG8_STAGE(PG8_SB(0, 1), cB + hstep, voffB); PG8_STAGE(PG8_SA(0, 1), cA + hstep, voffA);
    if (wr == 1) PG8_BAR;
    PG8_WAIT_V(4); PG8_BAR;
    PG8_STAGE(PG8_SB(1, 0), cB + kstep, voffB); PG8_STAGE(PG8_SA(1, 0), cA + kstep, voffA); PG8_STAGE(PG8_SB(1, 1), cB + hstep + kstep, voffB);
    PG8_WAIT_V(6); PG8_BAR;
    }
    for (;;) {
        const bool has_next = S.next(ui + 1, nxt);
        const char* nA = has_next ? (const char*)g.A + (size_t)nxt.pm * tstep : cA; const char* nB = has_next ? (const char*)g.Bt + (size_t)nxt.pn * tstep : cB;
        for (int t = 0; t < nt; t += 2) {
            const bool last = (t == nt - 2);
            const char* a1 = cA + (size_t)(t + 1) * kstep;
            const char* a2 = last ? nA : cA + (size_t)(t + 2) * kstep; const char* b2 = last ? nB : cB + (size_t)(t + 2) * kstep;
            const char* a3 = a2 + kstep; const char* b3 = b2 + kstep;
            if constexpr (SP2) {
            PG8_LDB(B0, 0, 0); PG8_LDB(B1, 0, 1); PG8_SCHED; PG8_LDA(At, 0, 0); PG8_STAGE(PG8_SA(1, 1), a1 + hstep, voffA);
            PG8_WAIT_V(8); PG8_WAIT_L(0); PG8_BAR; PG8_MMA(0, 0, At, B0); PG8_MMA(0, 1, At, B1); PG8_BAR; PG8_SCHED;
            PG8_LDA(At, 0, 1); PG8_STAGE(PG8_SB(0, 0), b2, voffB); PG8_STAGE(PG8_SB(0, 1), b2 + hstep, voffB); PG8_STAGE(PG8_SA(0, 0), a2, voffA);
            PG8_WAIT_V(8); PG8_WAIT_L(0); PG8_BAR; PG8_MMA(1, 0, At, B0); PG8_MMA(1, 1, At, B1); PG8_BAR; PG8_SCHED;
            PG8_LDB(B0, 1, 0); PG8_LDB(B1, 1, 1); PG8_SCHED; PG8_LDA(At, 1, 0); PG8_STAGE(PG8_SA(0, 1), a2 + hstep, voffA);
            PG8_WAIT_V(8); PG8_WAIT_L(0); PG8_BAR; PG8_MMA(0, 0, At, B0); PG8_MMA(0, 1, At, B1); PG8_BAR; PG8_SCHED;
            PG8_LDA(At, 1, 1); PG8_STAGE(PG8_SB(1, 0), b3, voffB); PG8_STAGE(PG8_SB(1, 1), b3 + hstep, voffB); PG8_STAGE(PG8_SA(1, 0), a3, voffA);
            PG8_WAIT_V(8); PG8_WAIT_L(0); PG8_BAR; PG8_MMA(1, 0, At, B0); PG8_MMA(1, 1, At, B1); PG8_BAR; PG8_SCHED;
            } else {
            PG8_LDB(B0, 0, 0); PG8_SCHED; PG8_LDA(At, 0, 0); PG8_STAGE(PG8_SA(1, 1), a1 + hstep, voffA);
            PG8_WAIT_L(8); PG8_BAR; PG8_WAIT_L(0); PG8_MMA(0, 0, At, B0); PG8_BAR; PG8_SCHED;
            PG8_LDB(B1, 0, 1); PG8_STAGE(PG8_SB(0, 0), b2, voffB);
            PG8_BAR; PG8_WAIT_L(0); PG8_MMA(0, 1, At, B1); PG8_BAR;
            PG8_LDA(At, 0, 1); PG8_STAGE(PG8_SA(0, 0), a2, voffA);
            PG8_BAR; PG8_WAIT_L(0); PG8_MMA(1, 0, At, B0); PG8_BAR; PG8_SCHED;
            PG8_STAGE(PG8_SB(0, 1), b2 + hstep, voffB);
            PG8_WAIT_V(6); PG8_BAR; PG8_MMA(1, 1, At, B1); PG8_BAR;
            PG8_LDB(B0, 1, 0); PG8_SCHED; PG8_LDA(At, 1, 0); PG8_STAGE(PG8_SA(0, 1), a2 + hstep, voffA);
            PG8_WAIT_L(8); PG8_BAR; PG8_WAIT_L(0); PG8_MMA(0, 0, At, B0); PG8_BAR; PG8_SCHED;
            PG8_LDB(B1, 1, 1); PG8_STAGE(PG8_SB(1, 0), b3, voffB);
            PG8_BAR; PG8_WAIT_L(0); PG8_MMA(0, 1, At, B1); PG8_BAR;
            PG8_LDA(At, 1, 1); PG8_STAGE(PG8_SA(1, 0), a3, voffA);
            PG8_BAR; PG8_WAIT_L(0); PG8_MMA(1, 0, At, B0); PG8_BAR; PG8_SCHED;
            PG8_STAGE(PG8_SB(1, 1), b3 + hstep, voffB);
            PG8_WAIT_V(6); PG8_BAR; PG8_MMA(1, 1, At, B1); PG8_BAR;
            }
        }
        if constexpr (ALIGN_EPI) { if (wr == 0) PG8_BAR; }
        E(acc, cur, wr, wc, fr, fq);
        if (!has_next) break;
#pragma unroll
        for (int a = 0; a < 2; ++a)
#pragma unroll
            for (int b = 0; b < 2; ++b)
#pragma unroll
                for (int m = 0; m < 4; ++m)
#pragma unroll
                    for (int n = 0; n < 2; ++n) acc[a][b][m][n] = (f32x4){0.f, 0.f, 0.f, 0.f};
        cur = nxt; cA = nA; cB = nB; ++ui;
        if constexpr (ALIGN_EPI) { if (wr == 1) PG8_BAR; }
    }
    PG8_WAIT_V(0);
    if constexpr (!ALIGN_EPI) { if (wr == 0) PG8_BAR; }
    PG8_BAR;
#undef PG8_SA
#undef PG8_SB
#undef PG8_STAGE
#undef PG8_LDA
#undef PG8_LDB
#undef PG8_MMA
#undef PG8_WAIT_V
#undef PG8_WAIT_L
#undef PG8_BAR
#undef PG8_SCHED
}
}

struct EpiPlain {
    static constexpr bool PERM = true;
    bf16_t* O; int ldc;
    DI void operator()(const f32x4 (&acc)[2][2][4][2], const pg8::Unit& u, int wr, int wc, int fr, int fq) const {
        const int row0 = u.pm * 256 + wr * 64 + fr, col0 = u.pn * 256 + wc * 32 + 8 * fq;
#pragma unroll
        for (int ai = 0; ai < 2; ++ai)
#pragma unroll
            for (int m = 0; m < 4; ++m) { bf16_t* rowp = O + (size_t)(row0 + ai * 128 + m * 16) * ldc + col0;
#pragma unroll
                for (int bj = 0; bj < 2; ++bj) { const f32x4 v0 = acc[ai][bj][m][0], v1 = acc[ai][bj][m][1];
                    u32x4 w; w.x = cvt_pk_bf16(v0[0], v0[1]); w.y = cvt_pk_bf16(v0[2], v0[3]); w.z = cvt_pk_bf16(v1[0], v1[1]); w.w = cvt_pk_bf16(v1[2], v1[3]);
                    *(u32x4*)(rowp + bj * 128) = w; } }
    }
};
struct EpiRelu2 {
    static constexpr bool PERM = true;
    bf16_t* O; int ldc;
    DI void operator()(const f32x4 (&acc)[2][2][4][2], const pg8::Unit& u, int wr, int wc, int fr, int fq) const {
        const int row0 = u.pm * 256 + wr * 64 + fr, col0 = u.pn * 256 + wc * 32 + 8 * fq;
#pragma unroll
        for (int ai = 0; ai < 2; ++ai)
#pragma unroll
            for (int m = 0; m < 4; ++m) { bf16_t* rowp = O + (size_t)(row0 + ai * 128 + m * 16) * ldc + col0;
#pragma unroll
                for (int bj = 0; bj < 2; ++bj) { f32x4 v0 = acc[ai][bj][m][0], v1 = acc[ai][bj][m][1];
#pragma unroll
                    for (int j = 0; j < 4; ++j) { const float a = fmaxf(v0[j], 0.f), b = fmaxf(v1[j], 0.f); v0[j] = a * a; v1[j] = b * b; }
                    u32x4 w; w.x = cvt_pk_bf16(v0[0], v0[1]); w.y = cvt_pk_bf16(v0[2], v0[3]); w.z = cvt_pk_bf16(v1[0], v1[1]); w.w = cvt_pk_bf16(v1[2], v1[3]);
                    *(u32x4*)(rowp + bj * 128) = w; } }
    }
};
struct EpiRes {
    static constexpr bool PERM = true;
    bf16_t* O; const bf16_t* R;
    DI void operator()(const f32x4 (&acc)[2][2][4][2], const pg8::Unit& u, int wr, int wc, int fr, int fq) const {
        const int row0 = u.pm * 256 + wr * 64 + fr, col0 = u.pn * 256 + wc * 32 + 8 * fq;
#pragma unroll
        for (int ai = 0; ai < 2; ++ai)
#pragma unroll
            for (int m = 0; m < 4; ++m) { const size_t off = (size_t)(row0 + ai * 128 + m * 16) * 1024 + col0;
#pragma unroll
                for (int bj = 0; bj < 2; ++bj) { const f32x4 v0 = acc[ai][bj][m][0], v1 = acc[ai][bj][m][1];
                    const u32x4 rr = *(const u32x4*)(R + off + bj * 128);
                    u32x4 w;
                    w.x = cvt_pk_bf16(ALPHA_C * bf_lo(rr.x) + v0[0], ALPHA_C * bf_hi(rr.x) + v0[1]); w.y = cvt_pk_bf16(ALPHA_C * bf_lo(rr.y) + v0[2], ALPHA_C * bf_hi(rr.y) + v0[3]);
                    w.z = cvt_pk_bf16(ALPHA_C * bf_lo(rr.z) + v1[0], ALPHA_C * bf_hi(rr.z) + v1[1]); w.w = cvt_pk_bf16(ALPHA_C * bf_lo(rr.w) + v1[2], ALPHA_C * bf_hi(rr.w) + v1[3]);
                    *(u32x4*)(O + off + bj * 128) = w; } }
    }
};
struct EpiQKV {
    static constexpr bool PERM = true;
    bf16_t* O; const float* rc; const float* rs;
    DI void operator()(const f32x4 (&acc)[2][2][4][2], const pg8::Unit& u, int wr, int wc, int fr, int fq) const {
        const int row0 = u.pm * 256 + wr * 64 + fr, col0 = u.pn * 256 + wc * 32 + 8 * fq;
        const bool rot = u.pn < 4; const int i0 = 16 * (wc & 1) + 4 * fq;
#pragma unroll
        for (int ai = 0; ai < 2; ++ai)
#pragma unroll
            for (int m = 0; m < 4; ++m) { const int row = row0 + ai * 128 + m * 16; bf16_t* rowp = O + (size_t)row * 3072 + col0;
                f32x4 c4 = (f32x4){1.f, 1.f, 1.f, 1.f}, s4 = (f32x4){0.f, 0.f, 0.f, 0.f};
                if (rot) { const int t = row & (row < MP ? 4095 : 8191); c4 = *(const f32x4*)(rc + t * 32 + i0); s4 = *(const f32x4*)(rs + t * 32 + i0); }
#pragma unroll
                for (int bj = 0; bj < 2; ++bj) { const f32x4 v0 = acc[ai][bj][m][0], v1 = acc[ai][bj][m][1];
                    const f32x4 o0 = v0 * c4 - v1 * s4, o1 = v1 * c4 + v0 * s4;
                    u32x4 w; w.x = cvt_pk_bf16(o0[0], o0[1]); w.y = cvt_pk_bf16(o0[2], o0[3]); w.z = cvt_pk_bf16(o1[0], o1[1]); w.w = cvt_pk_bf16(o1[2], o1[3]);
                    *(u32x4*)(rowp + bj * 128) = w; }
                asm volatile("" ::: "memory"); }
    }
};

DI void wave_sum2(float& a, float& b) { for (int o = 32; o >= 1; o >>= 1) { a += __shfl_xor(a, o); b += __shfl_xor(b, o); } }
DI void wave_sum4(float& a, float& b, float& c, float& d) { for (int o = 32; o >= 1; o >>= 1) { a += __shfl_xor(a, o); b += __shfl_xor(b, o); c += __shfl_xor(c, o); d += __shfl_xor(d, o); } }
template <bool OUTF32>
DI void ln_store(f32x4 v0, f32x4 v1, f32x4 v2, f32x4 v3, float mean, float rstd, const f32x4 (&g)[4], const f32x4 (&b)[4], bf16_t* __restrict__ X, float* __restrict__ OF, int row, int lane) {
    v0 = (v0 - mean) * rstd * g[0] + b[0]; v1 = (v1 - mean) * rstd * g[1] + b[1]; v2 = (v2 - mean) * rstd * g[2] + b[2]; v3 = (v3 - mean) * rstd * g[3] + b[3];
    if (OUTF32) { float* o = OF + (size_t)row * 1024; *(f32x4*)(o + lane * 8) = v0; *(f32x4*)(o + lane * 8 + 4) = v1; *(f32x4*)(o + 512 + lane * 8) = v2; *(f32x4*)(o + 516 + lane * 8) = v3; }
    else { u32x4 w; w.x = cvt_pk_bf16(v0[0], v0[1]); w.y = cvt_pk_bf16(v0[2], v0[3]); w.z = cvt_pk_bf16(v1[0], v1[1]); w.w = cvt_pk_bf16(v1[2], v1[3]);
        *(u32x4*)(X + (size_t)row * 1024 + lane * 8) = w;
        w.x = cvt_pk_bf16(v2[0], v2[1]); w.y = cvt_pk_bf16(v2[2], v2[3]); w.z = cvt_pk_bf16(v3[0], v3[1]); w.w = cvt_pk_bf16(v3[2], v3[3]);
        *(u32x4*)(X + (size_t)row * 1024 + 512 + lane * 8) = w; }
}
DI float hsum(const f32x4& t) { return (t[0] + t[1]) + (t[2] + t[3]); }
template <int LNA, int RES, int STATS, int ACT> struct EpiGen {
    static constexpr bool PERM = true;
    bf16_t* O; int ldc; const float* Sa; const float* c1; const float* c2; const bf16_t* R; const float* Sr; const float* gr; const float* br; float* So;
    DI void operator()(const f32x4 (&acc)[2][2][4][2], const pg8::Unit& u, int wr, int wc, int fr, int fq) const {
        const int row0 = u.pm * 256 + wr * 64 + fr, col0 = u.pn * 256 + wc * 32 + 8 * fq;
        f32x4 ka[2][2], kb[2][2];
#pragma unroll
        for (int bj = 0; bj < 2; ++bj)
#pragma unroll
            for (int n = 0; n < 2; ++n) {
                if (LNA) { ka[bj][n] = *(const f32x4*)(c1 + col0 + bj * 128 + 4 * n); kb[bj][n] = *(const f32x4*)(c2 + col0 + bj * 128 + 4 * n); }
                else if (RES == 2) { ka[bj][n] = *(const f32x4*)(gr + col0 + bj * 128 + 4 * n); kb[bj][n] = *(const f32x4*)(br + col0 + bj * 128 + 4 * n); }
                else { ka[bj][n] = (f32x4){0.f, 0.f, 0.f, 0.f}; kb[bj][n] = ka[bj][n]; } }
#pragma unroll
        for (int ai = 0; ai < 2; ++ai)
#pragma unroll
            for (int m = 0; m < 4; ++m) { const int row = row0 + ai * 128 + m * 16;
                float mean_a = 0.f, rstd_a = 1.f, mean_r = 0.f, rstd_r = 1.f;
                if (LNA) { const float sx = Sa[2 * row], sq = Sa[2 * row + 1]; mean_a = sx * (1.f / 1024.f); rstd_a = rsqrtf(fmaxf(sq * (1.f / 1024.f) - mean_a * mean_a, 0.f) + LN_EPS_C); }
                if (RES == 2) { const float sx = Sr[2 * row], sq = Sr[2 * row + 1]; mean_r = sx * (1.f / 1024.f); rstd_r = rsqrtf(fmaxf(sq * (1.f / 1024.f) - mean_r * mean_r, 0.f) + LN_EPS_C); }
                float ssum = 0.f, ssq = 0.f;
#pragma unroll
                for (int bj = 0; bj < 2; ++bj) { f32x4 v0 = acc[ai][bj][m][0], v1 = acc[ai][bj][m][1];
                    if (LNA) { v0 = (v0 - mean_a * ka[bj][0]) * rstd_a + kb[bj][0]; v1 = (v1 - mean_a * ka[bj][1]) * rstd_a + kb[bj][1]; }
                    if (ACT) {
#pragma unroll
                        for (int j = 0; j < 4; ++j) { const float a = fmaxf(v0[j], 0.f), b = fmaxf(v1[j], 0.f); v0[j] = a * a; v1[j] = b * b; } }
                    if (RES) { const u32x4 rr = *(const u32x4*)(R + (size_t)row * 1024 + col0 + bj * 128);
                        f32x4 r0 = (f32x4){bf_lo(rr.x), bf_hi(rr.x), bf_lo(rr.y), bf_hi(rr.y)}, r1 = (f32x4){bf_lo(rr.z), bf_hi(rr.z), bf_lo(rr.w), bf_hi(rr.w)};
                        if (RES == 2) { r0 = (r0 - mean_r) * rstd_r * ka[bj][0] + kb[bj][0]; r1 = (r1 - mean_r) * rstd_r * ka[bj][1] + kb[bj][1]; }
                        v0 += ALPHA_C * r0; v1 += ALPHA_C * r1; }
                    if (STATS) { ssum += (v0[0] + v0[1]) + (v0[2] + v0[3]) + (v1[0] + v1[1]) + (v1[2] + v1[3]);
                        ssq += (v0[0] * v0[0] + v0[1] * v0[1]) + (v0[2] * v0[2] + v0[3] * v0[3]) + (v1[0] * v1[0] + v1[1] * v1[1]) + (v1[2] * v1[2] + v1[3] * v1[3]); }
                    u32x4 w; w.x = cvt_pk_bf16(v0[0], v0[1]); w.y = cvt_pk_bf16(v0[2], v0[3]); w.z = cvt_pk_bf16(v1[0], v1[1]); w.w = cvt_pk_bf16(v1[2], v1[3]);
                    *(u32x4*)(O + (size_t)row * ldc + col0 + bj * 128) = w; }
                if (STATS) { ssum += __shfl_xor(ssum, 16); ssum += __shfl_xor(ssum, 32); ssq += __shfl_xor(ssq, 16); ssq += __shfl_xor(ssq, 32);
                    if (fq == 0) { unsafeAtomicAdd(So + 2 * row, ssum); unsafeAtomicAdd(So + 2 * row + 1, ssq); } }
            }
    }
};

DI void transpose_w(const float* __restrict__ W, int K, int N, bf16_t* __restrict__ Wt, int mode, const float* ga, const float* gb, int gw, int nw, int lane, float csc = 1.f) {
    const int nNb = N >> 6, units = nNb * (K >> 6);
    for (int u = gw; u < units; u += nw) {
        const int nb = u % nNb, kb = u / nNb, n = nb * 64 + lane; int src = n; float sc = 1.f;
        if (mode == 1) { if (n < 1024) { const int hd = n >> 6, p = n & 63, j = p >> 3, e = p & 7; src = (hd << 6) + (e < 4 ? 4 * j + e : 32 + 4 * j + (e - 4)); }
            if (n < 512 || (n >= 1536 && n < 2048)) sc = 0.125f; }
        if (mode == 4) sc = csc;
#pragma unroll
        for (int kk = 0; kk < 8; ++kk) { const int k0 = kb * 64 + kk * 8; float v[8];
#pragma unroll
            for (int j = 0; j < 8; ++j) { float x = W[(size_t)(k0 + j) * N + src] * sc; if (mode == 2) x *= (k0 + j < 512) ? ga[k0 + j] : gb[k0 + j - 512]; if (mode == 4) x *= ga[k0 + j]; v[j] = x; }
            u32x4 w; w.x = cvt_pk_bf16(v[0], v[1]); w.y = cvt_pk_bf16(v[2], v[3]); w.z = cvt_pk_bf16(v[4], v[5]); w.w = cvt_pk_bf16(v[6], v[7]);
            *(u32x4*)(Wt + (size_t)n * K + k0) = w; }
    }
}
DI void phase_prologue(const Params& p, int gw, int nw, int lane) {
    unsigned char* sm = p.out;
    transpose_w(p.w_in, 1024, 3072, (bf16_t*)(sm + SM_WIN), 1, nullptr, nullptr, gw, nw, lane);
    transpose_w(p.w_out, 1024, 1024, (bf16_t*)(sm + SM_WOUT), 2, p.g_mix_a, p.g_mix_b, gw, nw, lane);
    transpose_w(p.w_xq, 1024, 1024, (bf16_t*)(sm + SM_WXQ), 4, p.ln1_g, nullptr, gw, nw, lane, 0.0625f);
    transpose_w(p.w_xkv, 1024, 2048, (bf16_t*)(sm + SM_WXKV), 0, nullptr, nullptr, gw, nw, lane);
    transpose_w(p.w_xo, 1024, 1024, (bf16_t*)(sm + SM_WXO), 0, nullptr, nullptr, gw, nw, lane);
    transpose_w(p.w_up, 1024, 4096, (bf16_t*)(sm + SM_WUP), 4, p.ln2_g, nullptr, gw, nw, lane, 1.f);
    transpose_w(p.w_down, 4096, 1024, (bf16_t*)(sm + SM_WDOWN), 0, nullptr, nullptr, gw, nw, lane);
    { float* cp = (float*)(sm + SM_CP); const int gt0 = gw * 64 + lane, nt0 = nw * 64;
      for (int e = gt0; e < 16 * 5120; e += nt0) { const int ks = e / 5120, col = e - ks * 5120; const bool xq = col < 1024;
          const float* W = xq ? p.w_xq + col : p.w_up + (col - 1024); const int N = xq ? 1024 : 4096; const float csc = xq ? 0.0625f : 1.f;
          const float* gv = xq ? p.ln1_g : p.ln2_g; const float* bv = xq ? p.ln1_b : p.ln2_b; float a1 = 0.f, a2 = 0.f;
#pragma unroll 8
          for (int k = ks * 64; k < ks * 64 + 64; ++k) { const float w = W[(size_t)k * N] * csc; float x = w; x *= gv[k]; a1 += bf_lo(cvt_pk_bf16(x, 0.f)); a2 += bv[k] * w; }
          cp[ks * 5120 + col] = a1; cp[(16 + ks) * 5120 + col] = a2; } }
    { float* ss = (float*)(sm + SM_SMALL); const int gt0 = gw * 64 + lane, nt0 = nw * 64;
      for (int i = gt0; i < SS_TOTAL; i += nt0) { float v = 0.f;
          if (i < 3720) v = p.rpb[i]; else if (i >= SS_LN1G && i < SS_LN1G + 1024) v = p.ln1_g[i - SS_LN1G]; else if (i >= SS_LN1B && i < SS_LN1B + 1024) v = p.ln1_b[i - SS_LN1B];
          else if (i >= SS_LN2G && i < SS_LN2G + 1024) v = p.ln2_g[i - SS_LN2G]; else if (i >= SS_LN2B && i < SS_LN2B + 1024) v = p.ln2_b[i - SS_LN2B];
          ss[i] = v; } }
    { bf16_t* mb = (bf16_t*)(sm + SM_MEMB); const int gt = gw * 64 + lane, nt = nw * 64;
      for (int i = gt; i < NMEM * 1024 / 8; i += nt) { const int e = i * 8; const float* s = e < 4096 * 1024 ? p.mem_prompt + e : p.mem_sample + (e - 4096 * 1024);
          const f32x4 a = *(const f32x4*)s, b = *(const f32x4*)(s + 4); u32x4 w; w.x = cvt_pk_bf16(a[0], a[1]); w.y = cvt_pk_bf16(a[2], a[3]); w.z = cvt_pk_bf16(b[0], b[1]); w.w = cvt_pk_bf16(b[2], b[3]);
          *(u32x4*)(mb + e) = w; }
      float* rc = (float*)(sm + SM_RC); float* rs = (float*)(sm + SM_RS);
      for (int i = gt; i < 8192 * 32; i += nt) { const int t = i >> 5, f = i & 31; const float inv = powf(10000.0f, -(float)f / 32.0f); const float ang = (float)t * inv;
          const double a = (double)ang; const double kq = rint(a * 0.15915494309189535); const float r = (float)(a - kq * 6.283185307179586);
          rc[i] = cosf(r); rs[i] = sinf(r); } }
    bf16_t* XN = (bf16_t*)(p.ws + WS_XN);
    f32x4 g[4], b[4];
    g[0] = *(const f32x4*)(p.ln_in_g + lane * 8); g[1] = *(const f32x4*)(p.ln_in_g + lane * 8 + 4); g[2] = *(const f32x4*)(p.ln_in_g + 512 + lane * 8); g[3] = *(const f32x4*)(p.ln_in_g + 516 + lane * 8);
    b[0] = *(const f32x4*)(p.ln_in_b + lane * 8); b[1] = *(const f32x4*)(p.ln_in_b + lane * 8 + 4); b[2] = *(const f32x4*)(p.ln_in_b + 512 + lane * 8); b[3] = *(const f32x4*)(p.ln_in_b + 516 + lane * 8);
#pragma unroll 1
    for (int row = gw; row < MTOK; row += 2 * nw) {
        const int row2 = row + nw;
        const float* x = row < MP ? p.x_prompt + (size_t)row * 1024 : p.x_sample + (size_t)(row - MP) * 1024;
        const float* y = row2 < MP ? p.x_prompt + (size_t)row2 * 1024 : p.x_sample + (size_t)(row2 - MP) * 1024;
        const f32x4 v0 = *(const f32x4*)(x + lane * 8), v1 = *(const f32x4*)(x + lane * 8 + 4), v2 = *(const f32x4*)(x + 512 + lane * 8), v3 = *(const f32x4*)(x + 516 + lane * 8);
        const f32x4 u0 = *(const f32x4*)(y + lane * 8), u1 = *(const f32x4*)(y + lane * 8 + 4), u2 = *(const f32x4*)(y + 512 + lane * 8), u3 = *(const f32x4*)(y + 516 + lane * 8);
        float s1 = hsum((v0 + v1) + (v2 + v3)), q1 = hsum((v0 * v0 + v1 * v1) + (v2 * v2 + v3 * v3)), s2 = hsum((u0 + u1) + (u2 + u3)), q2 = hsum((u0 * u0 + u1 * u1) + (u2 * u2 + u3 * u3));
        wave_sum4(s1, q1, s2, q2);
        const float m1 = s1 * (1.f / 1024.f), m2 = s2 * (1.f / 1024.f);
        const float r1 = rsqrtf(fmaxf(q1 * (1.f / 1024.f) - m1 * m1, 0.f) + LN_EPS_C), r2 = rsqrtf(fmaxf(q2 * (1.f / 1024.f) - m2 * m2, 0.f) + LN_EPS_C);
        ln_store<false>(v0, v1, v2, v3, m1, r1, g, b, XN, nullptr, row, lane);
        ln_store<false>(u0, u1, u2, u3, m2, r2, g, b, XN, nullptr, row2, lane);
    }
}

template <bool OUTF32>
DI void phase_ln(const bf16_t* __restrict__ Z, const float* __restrict__ gam, const float* __restrict__ bet, bf16_t* __restrict__ X, float* __restrict__ OF, int gw, int nw, int lane) {
    f32x4 g[4], b[4];
    g[0] = *(const f32x4*)(gam + lane * 8); g[1] = *(const f32x4*)(gam + lane * 8 + 4); g[2] = *(const f32x4*)(gam + 512 + lane * 8); g[3] = *(const f32x4*)(gam + 516 + lane * 8);
    b[0] = *(const f32x4*)(bet + lane * 8); b[1] = *(const f32x4*)(bet + lane * 8 + 4); b[2] = *(const f32x4*)(bet + 512 + lane * 8); b[3] = *(const f32x4*)(bet + 516 + lane * 8);
#pragma unroll 1
    for (int row = gw; row < MTOK; row += 2 * nw) {
        const int row2 = row + nw;
        const u32x4 za = *(const u32x4*)(Z + (size_t)row * 1024 + lane * 8), zb = *(const u32x4*)(Z + (size_t)row * 1024 + 512 + lane * 8);
        const u32x4 zc = *(const u32x4*)(Z + (size_t)row2 * 1024 + lane * 8), zd = *(const u32x4*)(Z + (size_t)row2 * 1024 + 512 + lane * 8);
        const f32x4 v0 = (f32x4){bf_lo(za.x), bf_hi(za.x), bf_lo(za.y), bf_hi(za.y)}, v1 = (f32x4){bf_lo(za.z), bf_hi(za.z), bf_lo(za.w), bf_hi(za.w)};
        const f32x4 v2 = (f32x4){bf_lo(zb.x), bf_hi(zb.x), bf_lo(zb.y), bf_hi(zb.y)}, v3 = (f32x4){bf_lo(zb.z), bf_hi(zb.z), bf_lo(zb.w), bf_hi(zb.w)};
        const f32x4 u0 = (f32x4){bf_lo(zc.x), bf_hi(zc.x), bf_lo(zc.y), bf_hi(zc.y)}, u1 = (f32x4){bf_lo(zc.z), bf_hi(zc.z), bf_lo(zc.w), bf_hi(zc.w)};
        const f32x4 u2 = (f32x4){bf_lo(zd.x), bf_hi(zd.x), bf_lo(zd.y), bf_hi(zd.y)}, u3 = (f32x4){bf_lo(zd.z), bf_hi(zd.z), bf_lo(zd.w), bf_hi(zd.w)};
        float s1 = hsum((v0 + v1) + (v2 + v3)), q1 = hsum((v0 * v0 + v1 * v1) + (v2 * v2 + v3 * v3)), s2 = hsum((u0 + u1) + (u2 + u3)), q2 = hsum((u0 * u0 + u1 * u1) + (u2 * u2 + u3 * u3));
        wave_sum4(s1, q1, s2, q2);
        const float m1 = s1 * (1.f / 1024.f), m2 = s2 * (1.f / 1024.f);
        const float r1 = rsqrtf(fmaxf(q1 * (1.f / 1024.f) - m1 * m1, 0.f) + LN_EPS_C), r2 = rsqrtf(fmaxf(q2 * (1.f / 1024.f) - m2 * m2, 0.f) + LN_EPS_C);
        ln_store<OUTF32>(v0, v1, v2, v3, m1, r1, g, b, X, OF, row, lane);
        ln_store<OUTF32>(u0, u1, u2, u3, m2, r2, g, b, X, OF, row2, lane);
    }
}

constexpr int VROW = 144;
constexpr int VWAVE = 64 * VROW;
constexpr int LDS_RMS = 8 * VWAVE;
constexpr int LDS_RPB = LDS_RMS + 4096;

DI void tr_read8(unsigned addr, s16x4 (&r)[8]) {
    asm volatile("s_waitcnt lgkmcnt(0)\n\t"
                 "ds_read_b64_tr_b16 %0, %8 offset:0\n\t" "ds_read_b64_tr_b16 %1, %8 offset:2304\n\t"
                 "ds_read_b64_tr_b16 %2, %8 offset:32\n\t" "ds_read_b64_tr_b16 %3, %8 offset:2336\n\t"
                 "ds_read_b64_tr_b16 %4, %8 offset:64\n\t" "ds_read_b64_tr_b16 %5, %8 offset:2368\n\t"
                 "ds_read_b64_tr_b16 %6, %8 offset:96\n\t" "ds_read_b64_tr_b16 %7, %8 offset:2400\n\t"
                 "s_waitcnt lgkmcnt(0)"
                 : "=&v"(r[0]), "=&v"(r[1]), "=&v"(r[2]), "=&v"(r[3]), "=&v"(r[4]), "=&v"(r[5]), "=&v"(r[6]), "=&v"(r[7]) : "v"(addr) : "memory");
}

template <int NO>
DI void softmax_chunk(f32x4 (&s)[4], float& m, float& l, f32x4 (&o)[NO], bf16x8 (&pf)[2]) {
    float mx = fmaxf(fmaxf(fmaxf(s[0][0], s[0][1]), fmaxf(s[0][2], s[0][3])), fmaxf(fmaxf(s[1][0], s[1][1]), fmaxf(s[1][2], s[1][3])));
    mx = fmaxf(mx, fmaxf(fmaxf(fmaxf(s[2][0], s[2][1]), fmaxf(s[2][2], s[2][3])), fmaxf(fmaxf(s[3][0], s[3][1]), fmaxf(s[3][2], s[3][3]))));
    if (__builtin_amdgcn_ballot_w64(mx > m + 16.f)) {
        mx = fmaxf(mx, __shfl_xor(mx, 16)); mx = fmaxf(mx, __shfl_xor(mx, 32));
        const float mn = fmaxf(m, mx), alpha = __builtin_amdgcn_exp2f((m - mn) * LOG2E_C); m = mn; l *= alpha;
#pragma unroll
        for (int c = 0; c < NO; ++c) o[c] *= alpha;
    }
    const float nb = -m * LOG2E_C;
    float ps = 0.f;
#pragma unroll
    for (int kt = 0; kt < 4; ++kt)
#pragma unroll
        for (int e = 0; e < 4; ++e) { const float pv = __builtin_amdgcn_exp2f(s[kt][e] * LOG2E_C + nb); s[kt][e] = pv; ps += pv; }
    l += ps;
#pragma unroll
    for (int pr = 0; pr < 2; ++pr) { u32x4 w; w.x = cvt_pk_bf16(s[2 * pr][0], s[2 * pr][1]); w.y = cvt_pk_bf16(s[2 * pr][2], s[2 * pr][3]);
        w.z = cvt_pk_bf16(s[2 * pr + 1][0], s[2 * pr + 1][1]); w.w = cvt_pk_bf16(s[2 * pr + 1][2], s[2 * pr + 1][3]); pf[pr] = __builtin_bit_cast(bf16x8, w); }
}

template <int NCH, class KOff, class VOff, class Score>
DI void attn64_run(const char* __restrict__ qkvb, const bf16x8 q0, const bf16x8 q1, unsigned char* vl, int lane, f32x4 (&o)[4], float& m, float& l, KOff koff, VOff voff, Score score) {
    const int fr = lane & 15, fq = lane >> 4;
    const unsigned vaddr = (unsigned)(size_t)vl + (unsigned)((4 * fq + (fr >> 2)) * VROW + (fr & 3) * 8);
    unsigned char* vw = vl + (lane >> 3) * VROW + (lane & 7) * 16;
    const unsigned char* krd = vl + fr * VROW + fq * 16;
    u32x4 kr[8], vr[8];
#pragma unroll
    for (int it = 0; it < 8; ++it) kr[it] = *(const u32x4*)(qkvb + koff(0, it));
#pragma unroll
    for (int it = 0; it < 8; ++it) vr[it] = *(const u32x4*)(qkvb + voff(0, it));
#pragma unroll 1
    for (int c = 0; c < NCH; ++c) {
        u32x4 vc[8];
#pragma unroll
        for (int it = 0; it < 8; ++it) *(u32x4*)(vw + it * 8 * VROW) = kr[it];
#pragma unroll
        for (int it = 0; it < 8; ++it) vc[it] = vr[it];
        __builtin_amdgcn_fence(__ATOMIC_RELEASE, "wavefront");
        bf16x8 kc[4][2];
#pragma unroll
        for (int kt = 0; kt < 4; ++kt) { kc[kt][0] = *(const bf16x8*)(krd + kt * 16 * VROW); kc[kt][1] = *(const bf16x8*)(krd + kt * 16 * VROW + 64); }
        if (c + 1 < NCH) {
#pragma unroll
            for (int it = 0; it < 8; ++it) kr[it] = *(const u32x4*)(qkvb + koff(c + 1, it));
#pragma unroll
            for (int it = 0; it < 8; ++it) vr[it] = *(const u32x4*)(qkvb + voff(c + 1, it));
        }
        f32x4 s[4];
#pragma unroll
        for (int kt = 0; kt < 4; ++kt) { s[kt] = __builtin_amdgcn_mfma_f32_16x16x32_bf16(kc[kt][0], q0, (f32x4){0.f, 0.f, 0.f, 0.f}, 0, 0, 0); s[kt] = __builtin_amdgcn_mfma_f32_16x16x32_bf16(kc[kt][1], q1, s[kt], 0, 0, 0); }
#pragma unroll
        for (int kt = 0; kt < 4; ++kt)
#pragma unroll
            for (int e = 0; e < 4; ++e) s[kt][e] = score(c, s[kt][e], kt, e);
        bf16x8 pf[2];
        softmax_chunk<4>(s, m, l, o, pf);
#pragma unroll
        for (int it = 0; it < 8; ++it) *(u32x4*)(vw + it * 8 * VROW) = vc[it];
#pragma unroll
        for (int pr = 0; pr < 2; ++pr) { s16x4 t[8]; tr_read8(vaddr + pr * 32 * VROW, t);
#pragma unroll
            for (int dc = 0; dc < 4; ++dc) { const bf16x8 vf = __builtin_shufflevector(t[2 * dc], t[2 * dc + 1], 0, 1, 2, 3, 4, 5, 6, 7); o[dc] = __builtin_amdgcn_mfma_f32_16x16x32_bf16(vf, pf[pr], o[dc], 0, 0, 0); } }
    }
}

template <int NO>
DI void softmax_pair(f32x4& s0, f32x4& s1, float& m, float& l, f32x4 (&o)[NO], bf16x8& pf) {
    float mx = fmaxf(fmaxf(fmaxf(s0[0], s0[1]), fmaxf(s0[2], s0[3])), fmaxf(fmaxf(s1[0], s1[1]), fmaxf(s1[2], s1[3])));
    if (__builtin_amdgcn_ballot_w64(mx > m + 16.f)) {
        mx = fmaxf(mx, __shfl_xor(mx, 16)); mx = fmaxf(mx, __shfl_xor(mx, 32));
        const float mn = fmaxf(m, mx), alpha = __builtin_amdgcn_exp2f((m - mn) * LOG2E_C); m = mn; l *= alpha;
#pragma unroll
        for (int c = 0; c < NO; ++c) o[c] *= alpha;
    }
    const float nb = -m * LOG2E_C;
    float ps = 0.f;
#pragma unroll
    for (int e = 0; e < 4; ++e) { s0[e] = __builtin_amdgcn_exp2f(s0[e] * LOG2E_C + nb); s1[e] = __builtin_amdgcn_exp2f(s1[e] * LOG2E_C + nb); ps += s0[e] + s1[e]; }
    l += ps;
    u32x4 w; w.x = cvt_pk_bf16(s0[0], s0[1]); w.y = cvt_pk_bf16(s0[2], s0[3]); w.z = cvt_pk_bf16(s1[0], s1[1]); w.w = cvt_pk_bf16(s1[2], s1[3]); pf = __builtin_bit_cast(bf16x8, w);
}
template <int NG, class KOff, class VOff, class Score, class Use, class Full>
DI void attn_mg_run(const int nimg, const char* __restrict__ qkvb, unsigned char* vl, int lane, f32x4 (&o)[NG][4], float (&m)[NG], float (&l)[NG], const bf16x8 (&q0)[NG], const bf16x8 (&q1)[NG],
                    KOff koff, VOff voff, Score score, Use use, Full full) {
    const int fr = lane & 15, fq = lane >> 4;
    const unsigned vaddr = (unsigned)(size_t)vl + (unsigned)(32 * VROW + (4 * fq + (fr >> 2)) * VROW + (fr & 3) * 8);
    unsigned char* vw = vl + (lane >> 3) * VROW + (lane & 7) * 16;
    const unsigned char* krd = vl + fr * VROW + fq * 16;
    u32x4 kr[4], vr[4];
#pragma unroll
    for (int j = 0; j < 4; ++j) { kr[j] = *(const u32x4*)(qkvb + koff(0, j)); vr[j] = *(const u32x4*)(qkvb + voff(0, j)); }
#pragma unroll 1
    for (int i = 0; i < nimg; ++i) {
#pragma unroll
        for (int j = 0; j < 4; ++j) { *(u32x4*)(vw + j * 8 * VROW) = kr[j]; *(u32x4*)(vw + (32 + j * 8) * VROW) = vr[j]; }
        __builtin_amdgcn_fence(__ATOMIC_RELEASE, "wavefront");
        bf16x8 kc[2][2];
#pragma unroll
        for (int kt = 0; kt < 2; ++kt) { kc[kt][0] = *(const bf16x8*)(krd + kt * 16 * VROW); kc[kt][1] = *(const bf16x8*)(krd + kt * 16 * VROW + 64); }
        if (i + 1 < nimg) {
#pragma unroll
            for (int j = 0; j < 4; ++j) { kr[j] = *(const u32x4*)(qkvb + koff(i + 1, j)); vr[j] = *(const u32x4*)(qkvb + voff(i + 1, j)); }
        }
        bf16x8 pf[NG];
#pragma unroll
        for (int g = 0; g < NG; ++g) {
            if (use(i, g)) {
                f32x4 s0 = __builtin_amdgcn_mfma_f32_16x16x32_bf16(kc[0][0], q0[g], (f32x4){0.f, 0.f, 0.f, 0.f}, 0, 0, 0); s0 = __builtin_amdgcn_mfma_f32_16x16x32_bf16(kc[0][1], q1[g], s0, 0, 0, 0);
                f32x4 s1 = __builtin_amdgcn_mfma_f32_16x16x32_bf16(kc[1][0], q0[g], (f32x4){0.f, 0.f, 0.f, 0.f}, 0, 0, 0); s1 = __builtin_amdgcn_mfma_f32_16x16x32_bf16(kc[1][1], q1[g], s1, 0, 0, 0);
                if (!full(i, g)) {
#pragma unroll
                    for (int e = 0; e < 4; ++e) { s0[e] = score(i, g, s0[e], 0, e); s1[e] = score(i, g, s1[e], 1, e); } }
                softmax_pair<4>(s0, s1, m[g], l[g], o[g], pf[g]);
            }
        }
        s16x4 t[8]; tr_read8(vaddr, t);
        bf16x8 vf[4];
#pragma unroll
        for (int dc = 0; dc < 4; ++dc) vf[dc] = __builtin_shufflevector(t[2 * dc], t[2 * dc + 1], 0, 1, 2, 3, 4, 5, 6, 7);
#pragma unroll
        for (int g = 0; g < NG; ++g) {
            if (use(i, g)) {
#pragma unroll
                for (int dc = 0; dc < 4; ++dc) o[g][dc] = __builtin_amdgcn_mfma_f32_16x16x32_bf16(vf[dc], pf[g], o[g][dc], 0, 0, 0);
            }
        }
    }
}

DI void attn64_finish(f32x4 (&o)[4], float l, float* rms, int& par, int wid, int lane, bf16_t* __restrict__ dst  ) {
    const int fr = lane & 15, fq = lane >> 4;
    l += __shfl_xor(l, 16); l += __shfl_xor(l, 32);
    const float inv = 1.0f / l; float ss = 0.f;
#pragma unroll
    for (int c = 0; c < 4; ++c) { o[c] *= inv; ss += (o[c][0] * o[c][0] + o[c][1] * o[c][1]) + (o[c][2] * o[c][2] + o[c][3] * o[c][3]); }
    ss += __shfl_xor(ss, 16); ss += __shfl_xor(ss, 32);
    float* rb = rms + par * 128;
    if (fq == 0) rb[wid * 16 + fr] = ss;
    __syncthreads();
    float tot = 0.f;
#pragma unroll
    for (int w = 0; w < 8; ++w) tot += rb[w * 16 + fr];
    const float rstd = rsqrtf(tot * (1.f / 512.f) + LN_EPS_C);
#pragma unroll
    for (int c = 0; c < 4; ++c) { u32x2 w; w.x = cvt_pk_bf16(o[c][0] * rstd, o[c][1] * rstd); w.y = cvt_pk_bf16(o[c][2] * rstd, o[c][3] * rstd); *(u32x2*)(dst + 16 * c + 4 * fq) = w; }
    par ^= 1;
}

template <class Dst>
DI void attn64_finish4(f32x4 (&o)[4][4], float (&l)[4], float* rms, int& par, int wid, int lane, Dst dst) {
    const int fr = lane & 15, fq = lane >> 4;
    float* rb = rms + par * 512;
#pragma unroll
    for (int g = 0; g < 4; ++g) { float lt = l[g]; lt += __shfl_xor(lt, 16); lt += __shfl_xor(lt, 32);
        const float inv = 1.0f / lt; float ss = 0.f;
#pragma unroll
        for (int c = 0; c < 4; ++c) { o[g][c] *= inv; ss += (o[g][c][0] * o[g][c][0] + o[g][c][1] * o[g][c][1]) + (o[g][c][2] * o[g][c][2] + o[g][c][3] * o[g][c][3]); }
        ss += __shfl_xor(ss, 16); ss += __shfl_xor(ss, 32);
        if (fq == 0) rb[g * 128 + wid * 16 + fr] = ss; }
    __syncthreads();
#pragma unroll
    for (int g = 0; g < 4; ++g) { float tot = 0.f;
#pragma unroll
        for (int w = 0; w < 8; ++w) tot += rb[g * 128 + w * 16 + fr];
        const float rstd = rsqrtf(tot * (1.f / 512.f) + LN_EPS_C); bf16_t* d = dst(g);
#pragma unroll
        for (int c = 0; c < 4; ++c) { u32x2 w; w.x = cvt_pk_bf16(o[g][c][0] * rstd, o[g][c][1] * rstd); w.y = cvt_pk_bf16(o[g][c][2] * rstd, o[g][c][3] * rstd); *(u32x2*)(d + 16 * c + 4 * fq) = w; } }
    par ^= 1;
}

DI void phase_attn(const Params& p, unsigned char* shm, int wid, int lane, int vcu) {
    const bf16_t* QKV = (const bf16_t*)(p.ws + WS_QKV); bf16_t* O = (bf16_t*)(p.out + OUT_O); const char* qkvb = (const char*)QKV;
    const int fr = lane & 15, fq = lane >> 4, h = wid, l3 = lane >> 3, l7 = lane & 7;
    unsigned char* vl = shm + wid * VWAVE; float* rms = (float*)(shm + LDS_RMS); float* rpbs = (float*)(shm + LDS_RPB);
    for (int i = threadIdx.x; i < 8 * 465 + 192; i += 512) rpbs[i] = (i >= 96 && i < 96 + 8 * 465) ? ((const float*)(p.out + SM_SMALL))[SS_RPB + i - 96] : 0.f;
    __syncthreads();
    int par = 0;
    float* ML = (float*)(p.out + SM_ML);
    for (int item = vcu; item < MTOK / 256; item += gridDim.x) {
        const int row_base = item * 256; const int T_ = row_base < MP ? 4096 : 8192; const int bb_ = row_base < MP ? (row_base & ~4095) : MP + ((row_base - MP) & ~8191); const int t0_ = row_base - bb_;
        const unsigned kcolb = (unsigned)(512 + h * 64) * 2u + 16u * l7, vcolb = (unsigned)(1024 + h * 64) * 2u + 16u * l7;
#pragma unroll 1
        for (int blk = 0; blk < (NO_P1 ? 0 : 4); ++blk) {
            int t0 = t0_, bb = bb_, T = T_; asm volatile("" : "+s"(t0), "+s"(bb), "+s"(T));
            const int tb = t0 + 64 * blk, kb = tb - 64;
            f32x4 o[4][4]; float m[4], l[4]; bf16x8 q0[4], q1[4];
#pragma unroll
            for (int g = 0; g < 4; ++g) { const bf16_t* qp = QKV + (size_t)(bb + tb + 16 * g + fr) * 3072 + h * 64 + 8 * fq; q0[g] = *(const bf16x8*)qp; q1[g] = *(const bf16x8*)(qp + 32); m[g] = -1e30f; l[g] = 0.f;
#pragma unroll
                for (int c = 0; c < 4; ++c) o[g][c] = (f32x4){0.f, 0.f, 0.f, 0.f}; }
            auto koff = [&](int i, int j) -> unsigned { int jj = kb + 32 * i + 8 * j + l3; jj = jj < 0 ? 0 : (jj > T - 1 ? T - 1 : jj); return (unsigned)(bb + jj) * 6144u + kcolb; };
            auto voff = [&](int i, int j) -> unsigned { int jj = kb + 32 * i + 8 * j + l3; jj = jj < 0 ? 0 : (jj > T - 1 ? T - 1 : jj); return (unsigned)(bb + jj) * 6144u + vcolb; };
            auto score = [&](int i, int g, float sv, int kt, int e) -> float { const int jq = tb + 16 * g + fr, lo = jq - 64 < 0 ? 0 : jq - 64, hi = jq + 64 > T - 1 ? T - 1 : jq + 64;
                const int base = kb + 32 * i + 4 * fq - lo; return ((unsigned)(base + 16 * kt + e) <= (unsigned)(hi - lo)) ? sv : -INFINITY; };
            auto use = [&](int i, int g) -> bool { return !((i == 5 && g < 2) || (i == 0 && g >= 2)); };
            auto full = [&](int i, int g) -> bool { return false; };
            attn_mg_run<4>(6, qkvb, vl, lane, o, m, l, q0, q1, koff, voff, score, use, full);
#pragma unroll
            for (int g = 0; g < 4; ++g) { float lt = l[g]; lt += __shfl_xor(lt, 16); lt += __shfl_xor(lt, 32);
                const size_t qrow = (size_t)(bb + tb + 16 * g + fr); const float inv = 1.0f / lt; bf16_t* dst = O + qrow * 1024 + h * 64 + 4 * fq;
#pragma unroll
                for (int c = 0; c < 4; ++c) { u32x2 w; w.x = cvt_pk_bf16(o[g][c][0] * inv, o[g][c][1] * inv); w.y = cvt_pk_bf16(o[g][c][2] * inv, o[g][c][3] * inv); *(u32x2*)(dst + 16 * c) = w; }
                if (fq == 0) { float2 ml; ml.x = m[g]; ml.y = lt; *(float2*)(ML + (qrow * 8 + h) * 2) = ml; } }
        }
    }
    __syncthreads();
    for (int item = vcu; item < MTOK / 256; item += gridDim.x) {
        const int row_base = item * 256; const int T_ = row_base < MP ? 4096 : 8192; const int bb_ = row_base < MP ? (row_base & ~4095) : MP + ((row_base - MP) & ~8191); const int t0_ = row_base - bb_;
        const unsigned kcolb = (unsigned)(512 + h * 64) * 2u + 16u * l7, vcolb = (unsigned)(1024 + h * 64) * 2u + 16u * l7;
#pragma unroll 1
        for (int r4 = 0; r4 < (NO_P2 ? 0 : 4); ++r4) { const int ah = 0;
            int t0 = t0_, bb = bb_, T = T_; asm volatile("" : "+s"(t0), "+s"(bb), "+s"(T));
            f32x4 o[4][4]; float m[4], l[4]; bf16x8 q0[4], q1[4];
#pragma unroll
            for (int a = 0; a < 4; ++a) { const size_t qrow = (size_t)(bb + t0 + r4 + 4 * (ah + a) + 16 * fr);
                const bf16_t* qp = QKV + qrow * 3072 + h * 64 + 8 * fq; q0[a] = *(const bf16x8*)qp; q1[a] = *(const bf16x8*)(qp + 32);
                const float2 ml = *(const float2*)(ML + (qrow * 8 + h) * 2); m[a] = ml.x; l[a] = fq == 0 ? ml.y : 0.f; const bf16_t* src = O + qrow * 1024 + h * 64 + 4 * fq;
#pragma unroll
                for (int c = 0; c < 4; ++c) { const u32x2 w = *(const u32x2*)(src + 16 * c); o[a][c] = (f32x4){bf_lo(w.x) * ml.y, bf_hi(w.x) * ml.y, bf_lo(w.y) * ml.y, bf_hi(w.y) * ml.y}; } }
            {
                const int L = T >> 2, kb = (t0 >> 2) - 64;
                auto koff = [&](int i, int j) -> unsigned { int jj = kb + 32 * i + 8 * j + l3; jj = jj < 0 ? 0 : (jj > L - 1 ? L - 1 : jj); return (unsigned)(bb + 4 * jj + r4) * 6144u + kcolb; };
                auto voff = [&](int i, int j) -> unsigned { int jj = kb + 32 * i + 8 * j + l3; jj = jj < 0 ? 0 : (jj > L - 1 ? L - 1 : jj); return (unsigned)(bb + 4 * jj + r4) * 6144u + vcolb; };
                auto score = [&](int i, int g, float sv, int kt, int e) -> float { const int jq = (t0 >> 2) + ah + g + 4 * fr, lo = jq - 64 < 0 ? 0 : jq - 64, hi = jq + 64 > L - 1 ? L - 1 : jq + 64;
                    const int base = kb + 32 * i + 4 * fq - lo; return ((unsigned)(base + 16 * kt + e) <= (unsigned)(hi - lo)) ? sv : -INFINITY; };
                auto use = [&](int i, int g) -> bool { return true; };
                auto full = [&](int i, int g) -> bool { return false; };
                attn_mg_run<4>(6, qkvb, vl, lane, o, m, l, q0, q1, koff, voff, score, use, full);
            }
#pragma unroll
            for (int a = 0; a < 4; ++a) {
                const int r = r4 + 4 * (ah + a), L = T >> 4, kb = (t0 >> 4) - 64;
                f32x4 (&o1)[1][4] = *reinterpret_cast<f32x4 (*)[1][4]>(&o[a]); float (&m1)[1] = *reinterpret_cast<float (*)[1]>(&m[a]); float (&l1)[1] = *reinterpret_cast<float (*)[1]>(&l[a]);
                const bf16x8 (&qa)[1] = *reinterpret_cast<const bf16x8 (*)[1]>(&q0[a]); const bf16x8 (&qb)[1] = *reinterpret_cast<const bf16x8 (*)[1]>(&q1[a]);
                auto koff = [&](int i, int j) -> unsigned { int jj = kb + 32 * i + 8 * j + l3; jj = jj < 0 ? 0 : (jj > L - 1 ? L - 1 : jj); return (unsigned)(bb + 16 * jj + r) * 6144u + kcolb; };
                auto voff = [&](int i, int j) -> unsigned { int jj = kb + 32 * i + 8 * j + l3; jj = jj < 0 ? 0 : (jj > L - 1 ? L - 1 : jj); return (unsigned)(bb + 16 * jj + r) * 6144u + vcolb; };
                auto score = [&](int i, int g, float sv, int kt, int e) -> float { const int jq = (t0 >> 4) + fr, lo = jq - 64 < 0 ? 0 : jq - 64, hi = jq + 64 > L - 1 ? L - 1 : jq + 64;
                    const int base = kb + 32 * i + 4 * fq - lo; return ((unsigned)(base + 16 * kt + e) <= (unsigned)(hi - lo)) ? sv : -INFINITY; };
                auto use = [&](int i, int g) -> bool { return true; };
                auto full = [&](int i, int g) -> bool { return false; };
                attn_mg_run<1>(5, qkvb, vl, lane, o1, m1, l1, qa, qb, koff, voff, score, use, full);
            }
            attn64_finish4(o, l, rms, par, wid, lane, [&](int a) -> bf16_t* { return O + (size_t)(bb + t0 + r4 + 4 * a + 16 * fr) * 1024 + h * 64; });
        }
    }
    for (int item = vcu; item < MTOK / 64; item += gridDim.x) {
        const int row_base = item * 64; const int T = row_base < MP ? 4096 : 8192; const int bb = row_base < MP ? (row_base & ~4095) : MP + ((row_base - MP) & ~8191);
        const int rows = T >> 6, rq = (row_base - bb) >> 6; int rs = rq - 4; rs = rs < 0 ? 0 : (rs > rows - 8 ? rows - 8 : rs);
        const unsigned kcolb = (unsigned)(2048 + h * 64) * 2u + 16u * l7, vcolb = (unsigned)(2560 + h * 64) * 2u + 16u * l7;
        f32x4 o[4][4]; float m[4], l[4]; bf16x8 q0[4], q1[4];
#pragma unroll
        for (int g = 0; g < 4; ++g) { const bf16_t* qp = QKV + (size_t)(row_base + 16 * g + fr) * 3072 + 1536 + h * 64 + 8 * fq; q0[g] = *(const bf16x8*)qp; q1[g] = *(const bf16x8*)(qp + 32); m[g] = -1e30f; l[g] = 0.f;
#pragma unroll
            for (int c = 0; c < 4; ++c) o[g][c] = (f32x4){0.f, 0.f, 0.f, 0.f}; }
        const unsigned kb0 = (unsigned)(bb + rs * 64 + l3) * 6144u;
        const float* bl = rpbs + 96 + h * 465 + 15 + (rs - rq + 7) * 31 + 4 * fq - fr;
        const int rsm = rs & 7;
        auto koff = [&](int i, int j) -> unsigned { const int a = ((i >> 1) + 8 - rsm) & 7; return kb0 + (unsigned)(a * 64 + 32 * (i & 1) + 8 * j) * 6144u + kcolb; };
        auto voff = [&](int i, int j) -> unsigned { const int a = ((i >> 1) + 8 - rsm) & 7; return kb0 + (unsigned)(a * 64 + 32 * (i & 1) + 8 * j) * 6144u + vcolb; };
        auto score = [&](int i, int g, float sv, int kt, int e) -> float { const int qc = 16 * g + fr; int cs = qc - 8; cs = cs < 0 ? 0 : (cs > 48 ? 48 : cs);
            const float bias = bl[(((i >> 1) + 8 - rsm) & 7) * 31 + 32 * (i & 1) + 16 * kt + e - 16 * g];
            return ((unsigned)(32 * (i & 1) + 4 * fq - cs + 16 * kt + e) < 16u) ? sv + bias : -INFINITY; };
        auto use = [&](int i, int g) -> bool { return (i & 1) ? (g > 0) : (g < 3); };
        auto full = [&](int i, int g) -> bool { return false; };
        attn_mg_run<4>(16, qkvb, vl, lane, o, m, l, q0, q1, koff, voff, score, use, full);
        attn64_finish4(o, l, rms, par, wid, lane, [&](int g) -> bf16_t* { return O + (size_t)(row_base + 16 * g + fr) * 1024 + 512 + h * 64; });
    }
    __syncthreads();
}

constexpr int XK_PITCH = 528, XV_PITCH = 144, XK_BYTES = 64 * XK_PITCH, XV_BYTES = 256 * XV_PITCH;
DI void x_gload(const bf16_t* __restrict__ KM, const bf16_t* __restrict__ VTM, int bitem, int c, int tid, u32x4 (&r)[8]) {
    const int rb = bitem >> 2, h = bitem & 3, row0 = rb * 128; const int gb = row0 < MP ? (row0 >> 12) : 16 + ((row0 - MP) >> 13);
#pragma unroll
    for (int j = 0; j < 4; ++j) { const int q = tid + 512 * j; r[j] = *(const u32x4*)(KM + (size_t)(gb * 256 + 64 * c + (q >> 5)) * 1024 + h * 256 + (q & 31) * 8); }
#pragma unroll
    for (int j = 0; j < 4; ++j) { const int q = tid + 512 * j; r[4 + j] = *(const u32x4*)(VTM + (size_t)(h * 256 + (q >> 3)) * NMEM + gb * 256 + 64 * c + (q & 7) * 8); }
}
DI void x_lstore(unsigned char* kl, unsigned char* vl, int tid, const u32x4 (&r)[8]) {
#pragma unroll
    for (int j = 0; j < 4; ++j) { const int q = tid + 512 * j; *(u32x4*)(kl + (q >> 5) * XK_PITCH + (q & 31) * 16) = r[j]; }
#pragma unroll
    for (int j = 0; j < 4; ++j) { const int q = tid + 512 * j; *(u32x4*)(vl + (q >> 3) * XV_PITCH + (q & 7) * 16) = r[4 + j]; }
}
constexpr int XBUF = XK_BYTES + XV_BYTES;
DI void phase_xattn(const Params& p, unsigned char* shm, int wid, int lane) {
    const bf16_t* QX = (const bf16_t*)(p.ws + WS_QX); const bf16_t* KM = (const bf16_t*)(p.out + SM_KM); const bf16_t* VTM = (const bf16_t*)(p.out + SM_VTM); bf16_t* OC = (bf16_t*)(p.ws + WS_OC);
    const int fr = lane & 15, fq = lane >> 4, tid = threadIdx.x, G = gridDim.x;
    constexpr int NIT = (MTOK / 128) * 4;
    int bitem = blockIdx.x, step = 0;
    if (bitem < NIT) { u32x4 pre[8]; x_gload(KM, VTM, bitem, 0, tid, pre); x_lstore(shm, shm + XK_BYTES, tid, pre); }
    while (bitem < NIT) {
        const int rb = bitem >> 2, h = bitem & 3, row0 = rb * 128 + wid * 16;
        const bf16_t* qp = QX + (size_t)(row0 + fr) * 1024 + h * 256 + 8 * fq;
        bf16x8 qf[8];
#pragma unroll
        for (int ks = 0; ks < 8; ++ks) qf[ks] = *(const bf16x8*)(qp + 32 * ks);
        f32x4 o[16];
#pragma unroll
        for (int dc = 0; dc < 16; ++dc) o[dc] = (f32x4){0.f, 0.f, 0.f, 0.f};
        float m = -1e30f, l = 0.f;
#pragma unroll 1
        for (int c = 0; c < 4; ++c, ++step) {
            unsigned char* kl = shm + (step & 1) * XBUF; unsigned char* vl = kl + XK_BYTES;
            unsigned char* kn = shm + ((step & 1) ^ 1) * XBUF;
            const unsigned char* krd = kl + fr * XK_PITCH + fq * 16;
            const unsigned char* vrd = vl + fr * XV_PITCH + fq * 8;
            __syncthreads();
            const int nb = c < 3 ? bitem : bitem + G, nc = c < 3 ? c + 1 : 0; const bool has_next = nb < NIT;
            u32x4 pre[8];
            if (has_next) x_gload(KM, VTM, nb, nc, tid, pre);
            f32x4 s[4];
#pragma unroll
            for (int kt = 0; kt < 4; ++kt) { s[kt] = (f32x4){0.f, 0.f, 0.f, 0.f};
#pragma unroll
                for (int ks = 0; ks < 8; ++ks) { const bf16x8 kf = *(const bf16x8*)(krd + kt * 16 * XK_PITCH + ks * 64); s[kt] = __builtin_amdgcn_mfma_f32_16x16x32_bf16(kf, qf[ks], s[kt], 0, 0, 0); } }
            bf16x8 pf[2];
            softmax_chunk<16>(s, m, l, o, pf);
#pragma unroll
            for (int pr = 0; pr < 2; ++pr)
#pragma unroll
                for (int dc = 0; dc < 16; ++dc) { const unsigned char* vp = vrd + dc * 16 * XV_PITCH + pr * 64; const s16x4 lo = *(const s16x4*)vp, hi = *(const s16x4*)(vp + 32);
                    const bf16x8 vf = __builtin_shufflevector(lo, hi, 0, 1, 2, 3, 4, 5, 6, 7); o[dc] = __builtin_amdgcn_mfma_f32_16x16x32_bf16(vf, pf[pr], o[dc], 0, 0, 0); }
            if (has_next) x_lstore(kn, kn + XK_BYTES, tid, pre);
        }
        l += __shfl_xor(l, 16); l += __shfl_xor(l, 32);
        const float inv = 1.0f / l; bf16_t* dst = OC + (size_t)(row0 + fr) * 1024 + h * 256 + 4 * fq;
#pragma unroll
        for (int dc = 0; dc < 16; ++dc) { u32x2 w; w.x = cvt_pk_bf16(o[dc][0] * inv, o[dc][1] * inv); w.y = cvt_pk_bf16(o[dc][2] * inv, o[dc][3] * inv); *(u32x2*)(dst + 16 * dc) = w; }
        bitem += G;
    }
    __syncthreads();
}

#define XB_TMO      128
#define XB_XCNT(j)  (256  + 64 * (j))
#define XB_XSUB(j)  (1280 + 64 * (j))
#define XB_XGEN(j)  (2304 + 64 * (j))
#define XB_TOP      3328
#define XB_TOPGEN   3392
#define XCD_BAR_WORDS 3456
#define XB_SPIN_CAP (1u << 18)
__device__ __forceinline__ unsigned xb_ld(unsigned* p)              { return __hip_atomic_load(p, __ATOMIC_RELAXED, __HIP_MEMORY_SCOPE_AGENT); }
__device__ __forceinline__ unsigned xb_add(unsigned* p, unsigned v) { return __hip_atomic_fetch_add(p, v, __ATOMIC_RELAXED, __HIP_MEMORY_SCOPE_AGENT); }
__device__ __forceinline__ unsigned xb_xcc_id() { return (unsigned)__builtin_amdgcn_s_getreg((3 << 11) | 20) & 0xFu; }
#define XB_SPIN(cond, bar) do { unsigned _sp = 0; while (cond) { __builtin_amdgcn_s_sleep(1); \
    if ((++_sp & 255u) == 0u) { if (xb_ld(&(bar)[XB_TMO])) break; if (_sp > XB_SPIN_CAP) { atomicAdd(&(bar)[XB_TMO], 1u); break; } } } } while (0)
struct XcdBarrier { unsigned* bar; unsigned x; volatile PG8_LAS unsigned* st; };
__device__ __forceinline__ XcdBarrier xcd_barrier_post(unsigned* bar, volatile PG8_LAS unsigned* st) {
    XcdBarrier b; b.bar = bar; b.x = xb_xcc_id(); b.st = st;
    if (threadIdx.x == 0) (void)xb_add(&bar[XB_XCNT(b.x)], 1u);
    return b;
}
__device__ __forceinline__ void xcd_barrier_complete(unsigned* bar, unsigned x, unsigned& nloc, unsigned& nx) {
    const unsigned G = gridDim.x * gridDim.y * gridDim.z;
    unsigned sum, cnt, mine, sp = 0u;
    for (;;) {
        sum = 0u; cnt = 0u; mine = 0u;
#pragma unroll
        for (unsigned j = 0; j < 16; ++j) { const unsigned c = xb_ld(&bar[XB_XCNT(j)]); sum += c; cnt += (c > 0u) ? 1u : 0u; mine = (j == x) ? c : mine; }
        if (sum == G) break;
        __builtin_amdgcn_s_sleep(1);
        if ((++sp & 255u) == 0u) { if (xb_ld(&bar[XB_TMO])) break; if (sp > XB_SPIN_CAP) { atomicAdd(&bar[XB_TMO], 1u); break; } }
    }
    nloc = mine > 0u ? mine : 1u; nx = cnt > 0u ? cnt : 1u;
}
__device__ __forceinline__ void xcd_barrier(unsigned* bar_, volatile PG8_LAS unsigned* st_) {
    XcdBarrier b; b.bar = bar_; b.st = st_; b.x = 0u;
    asm volatile("s_waitcnt vmcnt(0)" ::: "memory");
    __syncthreads();
    if (threadIdx.x == 0) {
        unsigned* bar = b.bar; b.x = xb_xcc_id();
        __builtin_amdgcn_s_waitcnt(0);
        unsigned nloc = b.st[0], nx = b.st[1];
        if (nloc == 0u) { xcd_barrier_complete(bar, b.x, nloc, nx); b.st[0] = nloc; b.st[1] = nx; }
        const unsigned old = xb_add(&bar[XB_XSUB(b.x)], 1u);
        const unsigned gen = old / nloc;
        if (old + 1u == (gen + 1u) * nloc) {
            __builtin_amdgcn_fence(__ATOMIC_RELEASE, "agent");
            asm volatile("s_waitcnt vmcnt(0)" ::: "memory");
            const unsigned og = xb_add(&bar[XB_TOP], 1u);
            const unsigned tg = og / nx;
            if (og + 1u == (tg + 1u) * nx) xb_add(&bar[XB_TOPGEN], 1u);
            else XB_SPIN(xb_ld(&bar[XB_TOPGEN]) == tg, bar);
            __builtin_amdgcn_fence(__ATOMIC_ACQUIRE, "agent");
            xb_add(&bar[XB_XGEN(b.x)], 1u);
            asm volatile("s_waitcnt vmcnt(0)" ::: "memory");
        } else {
            XB_SPIN(xb_ld(&bar[XB_XGEN(b.x)]) == gen, bar);
            __builtin_amdgcn_fence(__ATOMIC_ACQUIRE, "agent");
            asm volatile("s_waitcnt vmcnt(0)" ::: "memory");
        }
    }
    __syncthreads();
}

constexpr int LDS_XB = 2 * (64 * 528 + 256 * 144);
constexpr int LDS_BYTES = LDS_XB + 64;
constexpr int NPHASE = 14;

__global__ void __launch_bounds__(512, 2) fwd_megakernel(const Params p) {
    extern __shared__ __attribute__((aligned(16))) unsigned char shm[];
    PG8_LAS unsigned char* lds = (PG8_LAS unsigned char*)shm;
    const int tid = threadIdx.x, wid = __builtin_amdgcn_readfirstlane(tid >> 6), lane = tid & 63;
    const int G = gridDim.x, gw = blockIdx.x * 8 + wid, nw = G * 8;
    unsigned char* ws = p.ws; unsigned char* sm = p.out;
    const int lo = p.ph_lo, hi = p.ph_hi;
    volatile PG8_LAS unsigned* xbst = (volatile PG8_LAS unsigned*)(lds + LDS_XB);
    if (tid < 16) xbst[tid] = 0u;
    __syncthreads();
    if (tid == 0) { const unsigned x = xb_xcc_id(); const unsigned idx = xb_add((unsigned*)(sm + SM_BAR) + XB_XCNT(x), 1u); xbst[2] = x; xbst[3] = idx; xbst[4] = blockIdx.x; xbst[5] = blockIdx.x; }
    __syncthreads();
#ifdef PROBE_TS
    unsigned long long ts[15]; ts[0] = __builtin_amdgcn_s_memrealtime();
#define STAMP(k) ts[(k) + 1] = __builtin_amdgcn_s_memrealtime()
#else
#define STAMP(k)
#endif
#define IN(k) (((PH_MASK >> (k)) & 1) && lo <= (k) && (k) < hi)
#define SEAM(k) do { if ((k) + 1 < hi) { if (lo < 0) { __threadfence(); cg::this_grid().sync(); }     \
        xcd_barrier((k) == 12 ? (unsigned*)(p.ws + WS_BAR2) : (unsigned*)(p.out + SM_BAR), (volatile PG8_LAS unsigned*)((PG8_LAS unsigned char*)shm + LDS_XB)); } STAMP(k); } while (0)
    if (IN(0)) { phase_prologue(p, gw, nw, lane); } if (lo <= 0 && 0 < hi) SEAM(0);
    if (lo <= 0 && 0 < hi) {
        if (tid == 0) { unsigned* bar = (unsigned*)(sm + SM_BAR); bool ok = (G % 8) == 0; unsigned pop = 0;
            for (unsigned j = 0; j < 16; ++j) { const unsigned c = xb_ld(&bar[XB_XCNT(j)]); if (c != 0u) { ++pop; if (c != (unsigned)G / 8u) ok = false; } }
            ok = ok && pop == 8u && xbst[2] < 8u;
            if (ok) { xbst[4] = xbst[2] * ((unsigned)G / 8u) + xbst[3];
                      xbst[5] = xbst[3] * 8u + xbst[2]; } }
        __syncthreads();
    }
    const int vcu = __builtin_amdgcn_readfirstlane((int)xbst[4]), cid = __builtin_amdgcn_readfirstlane((int)xbst[5]);
    if (IN(1)) {
        { const float* cp = (const float*)(sm + SM_CP); float* cv = (float*)(sm + SM_CV); const int gt0 = gw * 64 + lane;
          if (gt0 < 5120) { float a1 = 0.f, a2 = 0.f;
#pragma unroll
              for (int ks = 0; ks < 16; ++ks) { a1 += cp[ks * 5120 + gt0]; a2 += cp[(16 + ks) * 5120 + gt0]; }
              cv[gt0] = a1; cv[5120 + gt0] = a2; } }
        { pg8::StaticOrder S; pg8::Gemm g{(const bf16_t*)(ws + WS_XN), (const bf16_t*)(sm + SM_WIN), MTOK, 3072, 1024}; S.init(g.M, g.N, G, cid);
          EpiQKV E{(bf16_t*)(ws + WS_QKV), (const float*)(sm + SM_RC), (const float*)(sm + SM_RS)}; pg8::gemm_phase(lds, g, S, E); }
#if !defined(NO_KV)
        { pg8::StaticOrder S; pg8::Gemm g{(const bf16_t*)(sm + SM_MEMB), (const bf16_t*)(sm + SM_WXKV), NMEM, 1024, 1024}; S.init(g.M, g.N, G, cid);
          EpiPlain E{(bf16_t*)(sm + SM_KM), 1024}; pg8::gemm_phase(lds, g, S, E); }
        { pg8::StaticOrder S; pg8::Gemm g{(const bf16_t*)(sm + SM_WXKV) + (size_t)1024 * 1024, (const bf16_t*)(sm + SM_MEMB), 1024, NMEM, 1024}; S.init(g.M, g.N, G, (cid + 128) % G);
          EpiPlain E{(bf16_t*)(sm + SM_VTM), NMEM}; pg8::gemm_phase(lds, g, S, E); }
#endif
    } if (lo <= 1 && 1 < hi) SEAM(1);
    if (IN(2)) { phase_attn(p, shm, wid, lane, vcu);
#ifdef DUP_ATTN
        __syncthreads(); phase_attn(p, shm, wid, lane, vcu);
#endif
    } if (lo <= 2 && 2 < hi) SEAM(2);
    if (IN(3)) { pg8::StaticOrder S; pg8::Gemm g{(const bf16_t*)(sm + OUT_O), (const bf16_t*)(sm + SM_WOUT), MTOK, 1024, 1024}; S.init(g.M, g.N, G, cid);
        EpiGen<0, 1, 1, 0> E{(bf16_t*)(ws + WS_Z1), 1024, nullptr, nullptr, nullptr, (const bf16_t*)(ws + WS_XN), nullptr, nullptr, nullptr, (float*)(sm + SM_S1)}; pg8::gemm_phase(lds, g, S, E); } if (lo <= 3 && 3 < hi) SEAM(3);
    if (IN(5)) { pg8::StaticOrder S; pg8::Gemm g{(const bf16_t*)(ws + WS_Z1), (const bf16_t*)(sm + SM_WXQ), MTOK, 1024, 1024}; S.init(g.M, g.N, G, cid);
        EpiGen<1, 0, 0, 0> E{(bf16_t*)(ws + WS_QX), 1024, (const float*)(sm + SM_S1), (const float*)(sm + SM_CV), (const float*)(sm + SM_CV) + 5120, nullptr, nullptr, nullptr, nullptr, nullptr}; pg8::gemm_phase(lds, g, S, E); } if (lo <= 5 && 5 < hi) SEAM(5);
    if (IN(6)) { phase_xattn(p, shm, wid, lane); } if (lo <= 6 && 6 < hi) SEAM(6);
    if (IN(7)) { pg8::StaticOrder S; pg8::Gemm g{(const bf16_t*)(ws + WS_OC), (const bf16_t*)(sm + SM_WXO), MTOK, 1024, 1024}; S.init(g.M, g.N, G, cid);
        EpiGen<0, 2, 1, 0> E{(bf16_t*)(ws + WS_X2), 1024, nullptr, nullptr, nullptr, (const bf16_t*)(ws + WS_Z1), (const float*)(sm + SM_S1), (const float*)(sm + SM_SMALL) + SS_LN1G, (const float*)(sm + SM_SMALL) + SS_LN1B, (float*)(sm + SM_S2)};
        pg8::gemm_phase(lds, g, S, E); } if (lo <= 7 && 7 < hi) SEAM(7);
#define UPDOWN(ch) do { const size_t r0 = (size_t)(ch) * MP; \
        if (IN(9 + 2 * (ch))) { pg8::StaticOrder S; pg8::Gemm g{(const bf16_t*)(ws + WS_X2) + r0 * 1024, (const bf16_t*)(sm + SM_WUP), MP, 4096, 1024}; S.init(g.M, g.N, G, cid); \
            EpiGen<1, 0, 0, 1> E{(bf16_t*)(ws + WS_H), 4096, (const float*)(sm + SM_S2) + r0 * 2, (const float*)(sm + SM_CV) + 1024, (const float*)(sm + SM_CV) + 5120 + 1024, nullptr, nullptr, nullptr, nullptr, nullptr}; pg8::gemm_phase(lds, g, S, E); } if (lo <= 9 + 2 * (ch) && 9 + 2 * (ch) < hi) SEAM(9 + 2 * (ch)); \
        if (IN(10 + 2 * (ch))) { pg8::StaticOrder S; pg8::Gemm g{(const bf16_t*)(ws + WS_H), (const bf16_t*)(sm + SM_WDOWN), MP, 1024, 4096}; S.init(g.M, g.N, G, cid); \
            EpiGen<0, 2, 0, 0> E{(bf16_t*)(ws + WS_Z3) + r0 * 1024, 1024, nullptr, nullptr, nullptr, (const bf16_t*)(ws + WS_X2) + r0 * 1024, (const float*)(sm + SM_S2) + r0 * 2, (const float*)(sm + SM_SMALL) + SS_LN2G, (const float*)(sm + SM_SMALL) + SS_LN2B, nullptr}; pg8::gemm_phase(lds, g, S, E); } if (lo <= 10 + 2 * (ch) && 10 + 2 * (ch) < hi) SEAM(10 + 2 * (ch)); } while (0)
    UPDOWN(0);
    if (lo <= 11 && 11 < hi && blockIdx.x == 0) { for (int i = tid; i < XCD_BAR_WORDS; i += 512) ((unsigned*)(ws + WS_BAR2))[i] = 0u; }
    UPDOWN(1);
#ifdef PROBE_TS
    { const float tot = (float)(ts[13] - ts[0]); const float fa = (float)(ts[PROBE_A1 + 1] - ts[PROBE_A0]) / tot, fb = (float)(ts[PROBE_B1 + 1] - ts[PROBE_B0]) / tot;
      const float fa_q = floorf(fa * 32.f + 0.5f) * (1.f / 32.f), fb_q = floorf(fb * 32.f + 0.5f) * (1.f / 32.f);
      if (IN(13)) { phase_ln<true>((const bf16_t*)(ws + WS_Z3), p.ln3_g, p.ln3_b, nullptr, (float*)p.out, gw, nw, lane, 1.f + fa_q, 1000.f * fb_q); } }
#else
    if (IN(13)) { phase_ln<true>((const bf16_t*)(ws + WS_Z3), p.ln3_g, p.ln3_b, nullptr, (float*)p.out, gw, nw, lane); }
#endif
}

extern "C" void kernel_launch(void* const* d_in, const int* in_sizes, int n_in, void* d_out, int out_size, void* d_ws, size_t ws_size, hipStream_t stream) {
    static int grid = 0;
    if (grid == 0) {
        if (n_in != 22 || ws_size < WS_NEED || (size_t)out_size != (size_t)MTOK * 1024) { fprintf(stderr, "kernel_launch: unexpected shapes (n_in %d, ws %zu, out %d); nothing launched\n", n_in, ws_size, out_size); grid = -1; return; }
        int dev = 0, cus = 0, per_cu = 0;
        hipGetDevice(&dev); hipDeviceGetAttribute(&cus, hipDeviceAttributeMultiprocessorCount, dev);
        if (hipFuncSetAttribute((const void*)fwd_megakernel, hipFuncAttributeMaxDynamicSharedMemorySize, LDS_BYTES) != hipSuccess) { fprintf(stderr, "kernel_launch: hipFuncSetAttribute failed\n"); grid = -1; return; }
        if (hipOccupancyMaxActiveBlocksPerMultiprocessor(&per_cu, (const void*)fwd_megakernel, 512, LDS_BYTES) != hipSuccess || per_cu < 1) { fprintf(stderr, "kernel_launch: occupancy query says %d\n", per_cu); per_cu = 1; }
        (void)hipGetLastError();
        grid = cus * 1;
    }
    if (grid < 0) return;
    Params p{};
    const float** pp = (const float**)&p;
    for (int i = 0; i < 22; ++i) pp[i] = (const float*)d_in[i];
    p.out = (unsigned char*)d_out; p.ws = (unsigned char*)d_ws;
    if (hipMemsetAsync((unsigned char*)d_out + SM_BAR, 0, 65536 + 2 * MiB, stream) != hipSuccess) { fprintf(stderr, "kernel_launch: hipMemsetAsync of the barrier words failed\n"); return; }
#if N_LAUNCHES == 1
    p.ph_lo = 0; p.ph_hi = NPHASE;
    void* args[] = {(void*)&p};
    hipError_t e = hipLaunchCooperativeKernel((const void*)fwd_megakernel, dim3(grid), dim3(512), args, LDS_BYTES, stream);
    if (e != hipSuccess) fprintf(stderr, "cooperative launch failed: %s (grid %d)\n", hipGetErrorString(e), grid);
#else
    for (int ph = 0; ph < NPHASE; ++ph) { p.ph_lo = ph; p.ph_hi = ph + 1; hipLaunchKernelGGL(fwd_megakernel, dim3(grid), dim3(512), LDS_BYTES, stream, p); }
#endif
}
```

```cpp
#include <hip/hip_runtime.h>
#include <hip/hip_cooperative_groups.h>
#include <cstdio>
namespace cg = cooperative_groups;

#define DI __device__ __forceinline__
#define PG8_LAS __attribute__((address_space(3)))
typedef unsigned short bf16_t;
typedef short bf16x8 __attribute__((ext_vector_type(8)));
typedef short s16x4 __attribute__((ext_vector_type(4)));
typedef float f32x4 __attribute__((ext_vector_type(4)));
typedef unsigned u32x4 __attribute__((ext_vector_type(4)));
typedef unsigned u32x2 __attribute__((ext_vector_type(2)));

#ifndef NO_P1
#define NO_P1 0
#endif
#ifndef NO_P2
#define NO_P2 0
#endif
#ifndef PH_MASK
#define PH_MASK 0xffff
#endif
#ifndef N_LAUNCHES
#define N_LAUNCHES 1
#endif

constexpr int MTOK = 131072, MP = 65536, NMEM = 6144;
constexpr float ALPHA_C = 1.189207115002721f, LN_EPS_C = 1e-5f, LOG2E_C = 1.4426950408889634f;
constexpr size_t MiB = (size_t)1 << 20;
constexpr size_t WS_XN = 0, WS_QKV = 256 * MiB, WS_Z1 = 256 * MiB, WS_QX = 512 * MiB, WS_OC = 768 * MiB, WS_X1 = 0, WS_Z2 = 256 * MiB, WS_X2 = 512 * MiB, WS_H = 0, WS_Z3 = 768 * MiB;
constexpr size_t WS_NEED = 1024 * MiB;
constexpr size_t WS_BAR2 = 512 * MiB;
constexpr size_t OUT_O = 0, OUT_SM = 256 * MiB;
constexpr size_t SM_WIN = OUT_SM, SM_WOUT = SM_WIN + 6 * MiB, SM_WXQ = SM_WOUT + 2 * MiB, SM_WXKV = SM_WXQ + 2 * MiB, SM_WXO = SM_WXKV + 4 * MiB, SM_WUP = SM_WXO + 2 * MiB,
                 SM_WDOWN = SM_WUP + 8 * MiB, SM_MEMB = SM_WDOWN + 8 * MiB, SM_KM = SM_MEMB + 12 * MiB, SM_VTM = SM_KM + 12 * MiB, SM_RC = SM_VTM + 12 * MiB, SM_RS = SM_RC + 1 * MiB, SM_ML = SM_RS + 1 * MiB  , SM_BAR = SM_ML + 8 * MiB  , SM_S1 = SM_BAR + 65536  , SM_S2 = SM_S1 + 1 * MiB  ,
                 SM_SMALL = SM_S2 + 1 * MiB  ,
                 SM_CV = SM_SMALL + 65536  , SM_CP = SM_CV + 65536  ;
constexpr int SS_RPB = 0, SS_LN1G = 4096, SS_LN1B = 5120, SS_LN2G = 6144, SS_LN2B = 7168, SS_TOTAL = 8192;

struct Params {
    const float *x_prompt, *x_sample, *mem_prompt, *mem_sample, *ln_in_g, *ln_in_b, *w_in, *rpb, *g_mix_a, *g_mix_b, *w_out, *ln1_g, *ln1_b, *w_xq, *w_xkv, *w_xo, *ln2_g, *ln2_b, *w_up, *w_down, *ln3_g, *ln3_b;
    unsigned char* out; unsigned char* ws; int ph_lo, ph_hi;
};

typedef __bf16 bf16x2n __attribute__((ext_vector_type(2)));
typedef float f32x2n __attribute__((ext_vector_type(2)));
DI unsigned cvt_pk_bf16(float lo, float hi) { const f32x2n v = {lo, hi}; const bf16x2n b = __builtin_convertvector(v, bf16x2n); return __builtin_bit_cast(unsigned, b); }
DI float bf_lo(unsigned w) { return __uint_as_float(w << 16); }
DI float bf_hi(unsigned w) { return __uint_as_float(w & 0xffff0000u); }
DI float wave_sum(float v) { for (int o = 32; o >= 1; o >>= 1) v += __shfl_xor(v, o); return v; }

namespace pg8 {
constexpr int BM = 256, BK = 64, HALF = 128, HTB = HALF * BK * 2, STAGE_BYTES = 8 * HTB, NXCD = 8, WGM = 8;
__host__ __device__ __forceinline__ int lds_byte(int r, int c) { const int st = (r >> 4) * 2 + (c >> 5), rr = r & 15, cc = c & 31, ob = rr * 64 + cc * 2; return st * 1024 + (ob ^ (((ob >> 9) & 1) << 5)); }
__host__ __device__ __forceinline__ void stage_rc(int b, int& R, int& C) { const int st = b / 1024, sb = b % 1024, swz = sb ^ (((sb >> 9) & 1) << 5); R = (st >> 1) * 16 + swz / 64; C = (st & 1) * 32 + (swz % 64) / 2; }
__host__ __device__ __forceinline__ int perm32(int rho) { const int n = rho >> 4, i = rho & 15; return 8 * (i >> 2) + 4 * n + (i & 3); }
struct Unit { int pm, pn; };
struct Gemm { const bf16_t* A; const bf16_t* Bt; int M, N, K; };
struct StaticOrder {
    int nM, nN, nwg, G, c, rev;
    __device__ void init(int M, int N, int G_, int c_, int rev_ = 0) { nM = M / BM; nN = N / BM; nwg = nM * nN; G = G_; c = c_; rev = rev_; }
    __device__ bool next(int i, Unit& u) const {
        const long L = (long)i * G + c; if (L >= nwg) return false;
        int wgid = (int)L; { const int q = nwg / NXCD, r = nwg % NXCD, xcd = wgid % NXCD, off = wgid / NXCD; wgid = (xcd < r ? xcd * (q + 1) : r * (q + 1) + (xcd - r) * q) + off; }
        const int nig = WGM * nN, gid = wgid / nig, fm = gid * WGM, gsz = (nM - fm) < WGM ? (nM - fm) : WGM;
        u.pm = fm + ((wgid % nig) % gsz); u.pn = (wgid % nig) / gsz; if (rev) u.pm = nM - 1 - u.pm; return true;
    }
};

template <class Epi, bool ALIGN_EPI = true, bool SP2 = true>
__device__ __forceinline__ void gemm_phase(PG8_LAS unsigned char* lds, const Gemm g, const StaticOrder& S, const Epi& E) {
    const int tid = threadIdx.x, wid = __builtin_amdgcn_readfirstlane(tid >> 6), lane = tid & 63, wr = wid >> 2, wc = wid & 3, fr = lane & 15, fq = lane >> 4;
    const int K = g.K, nt = K / BK;
    unsigned voffA[2], voffB[2];
#pragma unroll
    for (int i = 0; i < 2; ++i) { int R, C; stage_rc(tid * 16 + i * 8192, R, C); const int Rb = Epi::PERM ? ((R & ~31) + perm32(R & 31)) : R;
        voffA[i] = (unsigned)(R * K + C) * 2u; voffB[i] = (unsigned)(Rb * K + C) * 2u; }
    const size_t kstep = (size_t)(BK * 2);
    const size_t hstep = (size_t)HALF * K * 2;
    const size_t tstep = 2 * hstep;
    const unsigned ldsw = (unsigned)wid * 1024u;
    const int aoff = lds_byte(wr * 64 + fr, fq * 8), boff = lds_byte(wc * 32 + fr, fq * 8);
#define PG8_SA(b, h) (((b) * 2 + (h)) * HTB)
#define PG8_SB(b, h) ((4 + (b) * 2 + (h)) * HTB)
#define PG8_STAGE(bufoff, gbase, voff) do { _Pragma("unroll") for (int _i = 0; _i < 2; ++_i) \
        __builtin_amdgcn_global_load_lds((const unsigned*)((const char*)(gbase) + (voff)[_i]), (PG8_LAS unsigned*)(lds + (bufoff) + ldsw + _i * 8192), 16, 0, 0); } while (0)
#define PG8_LDA(dst, b, h) do { _Pragma("unroll") for (int m = 0; m < 4; ++m) _Pragma("unroll") for (int k = 0; k < 2; ++k) dst[m][k] = *(const PG8_LAS bf16x8*)(lds + PG8_SA(b, h) + aoff + m * 2048 + k * 1024); } while (0)
#define PG8_LDB(dst, b, h) do { _Pragma("unroll") for (int n = 0; n < 2; ++n) _Pragma("unroll") for (int k = 0; k < 2; ++k) dst[n][k] = *(const PG8_LAS bf16x8*)(lds + PG8_SB(b, h) + boff + n * 2048 + k * 1024); } while (0)
#define PG8_MMA(ai, bj, At, Bt) do { __builtin_amdgcn_s_setprio(1); _Pragma("unroll") for (int m = 0; m < 4; ++m) _Pragma("unroll") for (int n = 0; n < 2; ++n) _Pragma("unroll") for (int k = 0; k < 2; ++k) \
        acc[ai][bj][m][n] = __builtin_amdgcn_mfma_f32_16x16x32_bf16(Bt[n][k], At[m][k], acc[ai][bj][m][n], 0, 0, 0); __builtin_amdgcn_s_setprio(0); } while (0)
#define PG8_WAIT_V(n) asm volatile("s_waitcnt vmcnt(" #n ")" ::: "memory")
#define PG8_WAIT_L(n) asm volatile("s_waitcnt lgkmcnt(" #n ")" ::: "memory")
#define PG8_BAR __builtin_amdgcn_s_barrier()
#define PG8_SCHED __builtin_amdgcn_sched_barrier(0)
    Unit cur, nxt; int ui = 0;
    if (!S.next(0, cur)) return;
    f32x4 acc[2][2][4][2];
#pragma unroll
    for (int a = 0; a < 2; ++a)
#pragma unroll
        for (int b = 0; b < 2; ++b)
#pragma unroll
            for (int m = 0; m < 4; ++m)
#pragma unroll
                for (int n = 0; n < 2; ++n) acc[a][b][m][n] = (f32x4){0.f, 0.f, 0.f, 0.f};
    bf16x8 At[4][2], B0[2][2], B1[2][2];
    const char* cA = (const char*)g.A + (size_t)cur.pm * tstep; const char* cB = (const char*)g.Bt + (size_t)cur.pn * tstep;
    if constexpr (SP2) {
        PG8_STAGE(PG8_SB(0, 0), cB, voffB); PG8_STAGE(PG8_SB(0, 1), cB + hstep, voffB); PG8_STAGE(PG8_SA(0, 0), cA, voffA); PG8_STAGE(PG8_SA(0, 1), cA + hstep, voffA);
        if (wr == 1) PG8_BAR;
        PG8_WAIT_V(2); PG8_BAR;
        PG8_STAGE(PG8_SB(1, 0), cB + kstep, voffB); PG8_STAGE(PG8_SA(1, 0), cA + kstep, voffA); PG8_STAGE(PG8_SB(1, 1), cB + hstep + kstep, voffB);
        PG8_WAIT_V(6); PG8_BAR;
    } else {
    PG8_STAGE(PG8_SB(0, 0), cB, voffB); PG8_STAGE(PG8_SA(0, 0), cA, voffA); PG8_STAGE(PG8_SB(0, 1), cB + hstep, voffB); PG8_STAGE(PG8_SA(0, 1), cA + hstep, voffA);
    if (wr == 1) PG8_BAR;
    PG8_WAIT_V(4); PG8_BAR;
    PG8_STAGE(PG8_SB(1, 0), cB + kstep, voffB); PG8_STAGE(PG8_SA(1, 0), cA + kstep, voffA); PG8_STAGE(PG8_SB(1, 1), cB + hstep + kstep, voffB);
    PG8_WAIT_V(6); PG8_BAR;
    }
    for (;;) {
        const bool has_next = S.next(ui + 1, nxt);
        const char* nA = has_next ? (const char*)g.A + (size_t)nxt.pm * tstep : cA; const char* nB = has_next ? (const char*)g.Bt + (size_t)nxt.pn * tstep : cB;
        for (int t = 0; t < nt; t += 2) {
            const bool last = (t == nt - 2);
            const char* a1 = cA + (size_t)(t + 1) * kstep;
            const char* a2 = last ? nA : cA + (size_t)(t + 2) * kstep; const char* b2 = last ? nB : cB + (size_t)(t + 2) * kstep;
            const char* a3 = a2 + kstep; const char* b3 = b2 + kstep;
            if constexpr (SP2) {
            PG8_LDB(B0, 0, 0); PG8_LDB(B1, 0, 1); PG8_SCHED; PG8_LDA(At, 0, 0); PG8_STAGE(PG8_SA(1, 1), a1 + hstep, voffA);
            PG8_WAIT_V(8); PG8_WAIT_L(0); PG8_BAR; PG8_MMA(0, 0, At, B0); PG8_MMA(0, 1, At, B1); PG8_BAR; PG8_SCHED;
            PG8_LDA(At, 0, 1); PG8_STAGE(PG8_SB(0, 0), b2, voffB); PG8_STAGE(PG8_SB(0, 1), b2 + hstep, voffB); PG8_STAGE(PG8_SA(0, 0), a2, voffA);
            PG8_WAIT_V(8); PG8_WAIT_L(0); PG8_BAR; PG8_MMA(1, 0, At, B0); PG8_MMA(1, 1, At, B1); PG8_BAR; PG8_SCHED;
            PG8_LDB(B0, 1, 0); PG8_LDB(B1, 1, 1); PG8_SCHED; PG8_LDA(At, 1, 0); PG8_STAGE(PG8_SA(0, 1), a2 + hstep, voffA);
            PG8_WAIT_V(8); PG8_WAIT_L(0); PG8_BAR; PG8_MMA(0, 0, At, B0); PG8_MMA(0, 1, At, B1); PG8_BAR; PG8_SCHED;
            PG8_LDA(At, 1, 1); PG8_STAGE(PG8_SB(1, 0), b3, voffB); PG8_STAGE(PG8_SB(1, 1), b3 + hstep, voffB); PG8_STAGE(PG8_SA(1, 0), a3, voffA);
            PG8_WAIT_V(8); PG8_WAIT_L(0); PG8_BAR; PG8_MMA(1, 0, At, B0); PG8_MMA(1, 1, At, B1); PG8_BAR; PG8_SCHED;
            } else {
            PG8_LDB(B0, 0, 0); PG8_SCHED; PG8_LDA(At, 0, 0); PG8_STAGE(PG8_SA(1, 1), a1 + hstep, voffA);
            PG8_WAIT_L(8); PG8_BAR; PG8_WAIT_L(0); PG8_MMA(0, 0, At, B0); PG8_BAR; PG8_SCHED;
            PG8_LDB(B1, 0, 1); PG8_STAGE(PG8_SB(0, 0), b2, voffB);
            PG8_BAR; PG8_WAIT_L(0); PG8_MMA(0, 1, At, B1); PG8_BAR;
            PG8_LDA(At, 0, 1); PG8_STAGE(PG8_SA(0, 0), a2, voffA);
            PG8_BAR; PG8_WAIT_L(0); PG8_MMA(1, 0, At, B0); PG8_BAR; PG8_SCHED;
            PG8_STAGE(PG8_SB(0, 1), b2 + hstep, voffB);
            PG8_WAIT_V(6); PG8_BAR; PG8_MMA(1, 1, At, B1); PG8_BAR;
            PG8_LDB(B0, 1, 0); PG8_SCHED; PG8_LDA(At, 1, 0); PG8_STAGE(PG8_SA(0, 1), a2 + hstep, voffA);
            PG8_WAIT_L(8); PG8_BAR; PG8_WAIT_L(0); PG8_MMA(0, 0, At, B0); PG8_BAR; PG8_SCHED;
            PG8_LDB(B1, 1, 1); PG8_STAGE(PG8_SB(1, 0), b3, voffB);
            PG8_BAR; PG8_WAIT_L(0); PG8_MMA(0, 1, At, B1); PG8_BAR;
            PG8_LDA(At, 1, 1); PG8_STAGE(PG8_SA(1, 0), a3, voffA);
            PG8_BAR; PG8_WAIT_L(0); PG8_MMA(1, 0, At, B0); PG8_BAR; PG8_SCHED;
            PG8_STAGE(PG8_SB(1, 1), b3 + hstep, voffB);
            PG8_WAIT_V(6); PG8_BAR; PG8_MMA(1, 1, At, B1); PG8_BAR;
            }
        }
        if constexpr (ALIGN_EPI) { if (wr == 0) PG8_BAR; }
        E(acc, cur, wr, wc, fr, fq);
        if (!has_next) break;
#pragma unroll
        for (int a = 0; a < 2; ++a)
#pragma unroll
            for (int b = 0; b < 2; ++b)
#pragma unroll
                for (int m = 0; m < 4; ++m)
#pragma unroll
                    for (int n = 0; n < 2; ++n) acc[a][b][m][n] = (f32x4){0.f, 0.f, 0.f, 0.f};
        cur = nxt; cA = nA; cB = nB; ++ui;
        if constexpr (ALIGN_EPI) { if (wr == 1) PG8_BAR; }
    }
    PG8_WAIT_V(0);
    if constexpr (!ALIGN_EPI) { if (wr == 0) PG8_BAR; }
    PG8_BAR;
#undef PG8_SA
#undef PG8_SB
#undef PG8_STAGE
#undef PG8_LDA
#undef PG8_LDB
#undef PG8_MMA
#undef PG8_WAIT_V
#undef PG8_WAIT_L
#undef PG8_BAR
#undef PG8_SCHED
}
}

struct EpiPlain {
    static constexpr bool PERM = true;
    bf16_t* O; int ldc;
    DI void operator()(const f32x4 (&acc)[2][2][4][2], const pg8::Unit& u, int wr, int wc, int fr, int fq) const {
        const int row0 = u.pm * 256 + wr * 64 + fr, col0 = u.pn * 256 + wc * 32 + 8 * fq;
#pragma unroll
        for (int ai = 0; ai < 2; ++ai)
#pragma unroll
            for (int m = 0; m < 4; ++m) { bf16_t* rowp = O + (size_t)(row0 + ai * 128 + m * 16) * ldc + col0;
#pragma unroll
                for (int bj = 0; bj < 2; ++bj) { const f32x4 v0 = acc[ai][bj][m][0], v1 = acc[ai][bj][m][1];
                    u32x4 w; w.x = cvt_pk_bf16(v0[0], v0[1]); w.y = cvt_pk_bf16(v0[2], v0[3]); w.z = cvt_pk_bf16(v1[0], v1[1]); w.w = cvt_pk_bf16(v1[2], v1[3]);
                    *(u32x4*)(rowp + bj * 128) = w; } }
    }
};
struct EpiRelu2 {
    static constexpr bool PERM = true;
    bf16_t* O; int ldc;
    DI void operator()(const f32x4 (&acc)[2][2][4][2], const pg8::Unit& u, int wr, int wc, int fr, int fq) const {
        const int row0 = u.pm * 256 + wr * 64 + fr, col0 = u.pn * 256 + wc * 32 + 8 * fq;
#pragma unroll
        for (int ai = 0; ai < 2; ++ai)
#pragma unroll
            for (int m = 0; m < 4; ++m) { bf16_t* rowp = O + (size_t)(row0 + ai * 128 + m * 16) * ldc + col0;
#pragma unroll
                for (int bj = 0; bj < 2; ++bj) { f32x4 v0 = acc[ai][bj][m][0], v1 = acc[ai][bj][m][1];
#pragma unroll
                    for (int j = 0; j < 4; ++j) { const float a = fmaxf(v0[j], 0.f), b = fmaxf(v1[j], 0.f); v0[j] = a * a; v1[j] = b * b; }
                    u32x4 w; w.x = cvt_pk_bf16(v0[0], v0[1]); w.y = cvt_pk_bf16(v0[2], v0[3]); w.z = cvt_pk_bf16(v1[0], v1[1]); w.w = cvt_pk_bf16(v1[2], v1[3]);
                    *(u32x4*)(rowp + bj * 128) = w; } }
    }
};
struct EpiRes {
    static constexpr bool PERM = true;
    bf16_t* O; const bf16_t* R;
    DI void operator()(const f32x4 (&acc)[2][2][4][2], const pg8::Unit& u, int wr, int wc, int fr, int fq) const {
        const int row0 = u.pm * 256 + wr * 64 + fr, col0 = u.pn * 256 + wc * 32 + 8 * fq;
#pragma unroll
        for (int ai = 0; ai < 2; ++ai)
#pragma unroll
            for (int m = 0; m < 4; ++m) { const size_t off = (size_t)(row0 + ai * 128 + m * 16) * 1024 + col0;
#pragma unroll
                for (int bj = 0; bj < 2; ++bj) { const f32x4 v0 = acc[ai][bj][m][0], v1 = acc[ai][bj][m][1];
                    const u32x4 rr = *(const u32x4*)(R + off + bj * 128);
                    u32x4 w;
                    w.x = cvt_pk_bf16(ALPHA_C * bf_lo(rr.x) + v0[0], ALPHA_C * bf_hi(rr.x) + v0[1]); w.y = cvt_pk_bf16(ALPHA_C * bf_lo(rr.y) + v0[2], ALPHA_C * bf_hi(rr.y) + v0[3]);
                    w.z = cvt_pk_bf16(ALPHA_C * bf_lo(rr.z) + v1[0], ALPHA_C * bf_hi(rr.z) + v1[1]); w.w = cvt_pk_bf16(ALPHA_C * bf_lo(rr.w) + v1[2], ALPHA_C * bf_hi(rr.w) + v1[3]);
                    *(u32x4*)(O + off + bj * 128) = w; } }
    }
};
struct EpiQKV {
    static constexpr bool PERM = true;
    bf16_t* O; const float* rc; const float* rs;
    DI void operator()(const f32x4 (&acc)[2][2][4][2], const pg8::Unit& u, int wr, int wc, int fr, int fq) const {
        const int row0 = u.pm * 256 + wr * 64 + fr, col0 = u.pn * 256 + wc * 32 + 8 * fq;
        const bool rot = u.pn < 4; const int i0 = 16 * (wc & 1) + 4 * fq;
#pragma unroll
        for (int ai = 0; ai < 2; ++ai)
#pragma unroll
            for (int m = 0; m < 4; ++m) { const int row = row0 + ai * 128 + m * 16; bf16_t* rowp = O + (size_t)row * 3072 + col0;
                f32x4 c4 = (f32x4){1.f, 1.f, 1.f, 1.f}, s4 = (f32x4){0.f, 0.f, 0.f, 0.f};
                if (rot) { const int t = row & (row < MP ? 4095 : 8191); c4 = *(const f32x4*)(rc + t * 32 + i0); s4 = *(const f32x4*)(rs + t * 32 + i0); }
#pragma unroll
                for (int bj = 0; bj < 2; ++bj) { const f32x4 v0 = acc[ai][bj][m][0], v1 = acc[ai][bj][m][1];
                    const f32x4 o0 = v0 * c4 - v1 * s4, o1 = v1 * c4 + v0 * s4;
                    u32x4 w; w.x = cvt_pk_bf16(o0[0], o0[1]); w.y = cvt_pk_bf16(o0[2], o0[3]); w.z = cvt_pk_bf16(o1[0], o1[1]); w.w = cvt_pk_bf16(o1[2], o1[3]);
                    *(u32x4*)(rowp + bj * 128) = w; }
                asm volatile("" ::: "memory"); }
    }
};

DI void wave_sum2(float& a, float& b) { for (int o = 32; o >= 1; o >>= 1) { a += __shfl_xor(a, o); b += __shfl_xor(b, o); } }
DI void wave_sum4(float& a, float& b, float& c, float& d) { for (int o = 32; o >= 1; o >>= 1) { a += __shfl_xor(a, o); b += __shfl_xor(b, o); c += __shfl_xor(c, o); d += __shfl_xor(d, o); } }
template <bool OUTF32>
DI void ln_store(f32x4 v0, f32x4 v1, f32x4 v2, f32x4 v3, float mean, float rstd, const f32x4 (&g)[4], const f32x4 (&b)[4], bf16_t* __restrict__ X, float* __restrict__ OF, int row, int lane) {
    v0 = (v0 - mean) * rstd * g[0] + b[0]; v1 = (v1 - mean) * rstd * g[1] + b[1]; v2 = (v2 - mean) * rstd * g[2] + b[2]; v3 = (v3 - mean) * rstd * g[3] + b[3];
    if (OUTF32) { float* o = OF + (size_t)row * 1024; *(f32x4*)(o + lane * 8) = v0; *(f32x4*)(o + lane * 8 + 4) = v1; *(f32x4*)(o + 512 + lane * 8) = v2; *(f32x4*)(o + 516 + lane * 8) = v3; }
    else { u32x4 w; w.x = cvt_pk_bf16(v0[0], v0[1]); w.y = cvt_pk_bf16(v0[2], v0[3]); w.z = cvt_pk_bf16(v1[0], v1[1]); w.w = cvt_pk_bf16(v1[2], v1[3]);
        *(u32x4*)(X + (size_t)row * 1024 + lane * 8) = w;
        w.x = cvt_pk_bf16(v2[0], v2[1]); w.y = cvt_pk_bf16(v2[2], v2[3]); w.z = cvt_pk_bf16(v3[0], v3[1]); w.w = cvt_pk_bf16(v3[2], v3[3]);
        *(u32x4*)(X + (size_t)row * 1024 + 512 + lane * 8) = w; }
}
DI float hsum(const f32x4& t) { return (t[0] + t[1]) + (t[2] + t[3]); }
template <int LNA, int RES, int STATS, int ACT> struct EpiGen {
    static constexpr bool PERM = true;
    bf16_t* O; int ldc; const float* Sa; const float* c1; const float* c2; const bf16_t* R; const float* Sr; const float* gr; const float* br; float* So;
    DI void operator()(const f32x4 (&acc)[2][2][4][2], const pg8::Unit& u, int wr, int wc, int fr, int fq) const {
        const int row0 = u.pm * 256 + wr * 64 + fr, col0 = u.pn * 256 + wc * 32 + 8 * fq;
        f32x4 ka[2][2], kb[2][2];
#pragma unroll
        for (int bj = 0; bj < 2; ++bj)
#pragma unroll
            for (int n = 0; n < 2; ++n) {
                if (LNA) { ka[bj][n] = *(const f32x4*)(c1 + col0 + bj * 128 + 4 * n); kb[bj][n] = *(const f32x4*)(c2 + col0 + bj * 128 + 4 * n); }
                else if (RES == 2) { ka[bj][n] = *(const f32x4*)(gr + col0 + bj * 128 + 4 * n); kb[bj][n] = *(const f32x4*)(br + col0 + bj * 128 + 4 * n); }
                else { ka[bj][n] = (f32x4){0.f, 0.f, 0.f, 0.f}; kb[bj][n] = ka[bj][n]; } }
#pragma unroll
        for (int ai = 0; ai < 2; ++ai)
#pragma unroll
            for (int m = 0; m < 4; ++m) { const int row = row0 + ai * 128 + m * 16;
                float mean_a = 0.f, rstd_a = 1.f, mean_r = 0.f, rstd_r = 1.f;
                if (LNA) { const float sx = Sa[2 * row], sq = Sa[2 * row + 1]; mean_a = sx * (1.f / 1024.f); rstd_a = rsqrtf(fmaxf(sq * (1.f / 1024.f) - mean_a * mean_a, 0.f) + LN_EPS_C); }
                if (RES == 2) { const float sx = Sr[2 * row], sq = Sr[2 * row + 1]; mean_r = sx * (1.f / 1024.f); rstd_r = rsqrtf(fmaxf(sq * (1.f / 1024.f) - mean_r * mean_r, 0.f) + LN_EPS_C); }
                float ssum = 0.f, ssq = 0.f;
#pragma unroll
                for (int bj = 0; bj < 2; ++bj) { f32x4 v0 = acc[ai][bj][m][0], v1 = acc[ai][bj][m][1];
                    if (LNA) { v0 = (v0 - mean_a * ka[bj][0]) * rstd_a + kb[bj][0]; v1 = (v1 - mean_a * ka[bj][1]) * rstd_a + kb[bj][1]; }
                    if (ACT) {
#pragma unroll
                        for (int j = 0; j < 4; ++j) { const float a = fmaxf(v0[j], 0.f), b = fmaxf(v1[j], 0.f); v0[j] = a * a; v1[j] = b * b; } }
                    if (RES) { const u32x4 rr = *(const u32x4*)(R + (size_t)row * 1024 + col0 + bj * 128);
                        f32x4 r0 = (f32x4){bf_lo(rr.x), bf_hi(rr.x), bf_lo(rr.y), bf_hi(rr.y)}, r1 = (f32x4){bf_lo(rr.z), bf_hi(rr.z), bf_lo(rr.w), bf_hi(rr.w)};
                        if (RES == 2) { r0 = (r0 - mean_r) * rstd_r * ka[bj][0] + kb[bj][0]; r1 = (r1 - mean_r) * rstd_r * ka[bj][1] + kb[bj][1]; }
                        v0 += ALPHA_C * r0; v1 += ALPHA_C * r1; }
                    if (STATS) { ssum += (v0[0] + v0[1]) + (v0[2] + v0[3]) + (v1[0] + v1[1]) + (v1[2] + v1[3]);
                        ssq += (v0[0] * v0[0] + v0[1] * v0[1]) + (v0[2] * v0[2] + v0[3] * v0[3]) + (v1[0] * v1[0] + v1[1] * v1[1]) + (v1[2] * v1[2] + v1[3] * v1[3]); }
                    u32x4 w; w.x = cvt_pk_bf16(v0[0], v0[1]); w.y = cvt_pk_bf16(v0[2], v0[3]); w.z = cvt_pk_bf16(v1[0], v1[1]); w.w = cvt_pk_bf16(v1[2], v1[3]);
                    *(u32x4*)(O + (size_t)row * ldc + col0 + bj * 128) = w; }
                if (STATS) { ssum += __shfl_xor(ssum, 16); ssum += __shfl_xor(ssum, 32); ssq += __shfl_xor(ssq, 16); ssq += __shfl_xor(ssq, 32);
                    if (fq == 0) { unsafeAtomicAdd(So + 2 * row, ssum); unsafeAtomicAdd(So + 2 * row + 1, ssq); } }
            }
    }
};

DI void transpose_w(const float* __restrict__ W, int K, int N, bf16_t* __restrict__ Wt, int mode, const float* ga, const float* gb, int gw, int nw, int lane, float csc = 1.f) {
    const int nNb = N >> 6, units = nNb * (K >> 6);
    for (int u = gw; u < units; u += nw) {
        const int nb = u % nNb, kb = u / nNb, n = nb * 64 + lane; int src = n; float sc = 1.f;
        if (mode == 1) { if (n < 1024) { const int hd = n >> 6, p = n & 63, j = p >> 3, e = p & 7; src = (hd << 6) + (e < 4 ? 4 * j + e : 32 + 4 * j + (e - 4)); }
            if (n < 512 || (n >= 1536 && n < 2048)) sc = 0.125f; }
        if (mode == 4) sc = csc;
#pragma unroll
        for (int kk = 0; kk < 8; ++kk) { const int k0 = kb * 64 + kk * 8; float v[8];
#pragma unroll
            for (int j = 0; j < 8; ++j) { float x = W[(size_t)(k0 + j) * N + src] * sc; if (mode == 2) x *= (k0 + j < 512) ? ga[k0 + j] : gb[k0 + j - 512]; if (mode == 4) x *= ga[k0 + j]; v[j] = x; }
            u32x4 w; w.x = cvt_pk_bf16(v[0], v[1]); w.y = cvt_pk_bf16(v[2], v[3]); w.z = cvt_pk_bf16(v[4], v[5]); w.w = cvt_pk_bf16(v[6], v[7]);
            *(u32x4*)(Wt + (size_t)n * K + k0) = w; }
    }
}
DI void phase_prologue(const Params& p, int gw, int nw, int lane) {
    unsigned char* sm = p.out;
    transpose_w(p.w_in, 1024, 3072, (bf16_t*)(sm + SM_WIN), 1, nullptr, nullptr, gw, nw, lane);
    transpose_w(p.w_out, 1024, 1024, (bf16_t*)(sm + SM_WOUT), 2, p.g_mix_a, p.g_mix_b, gw, nw, lane);
    transpose_w(p.w_xq, 1024, 1024, (bf16_t*)(sm + SM_WXQ), 4, p.ln1_g, nullptr, gw, nw, lane, 0.0625f);
    transpose_w(p.w_xkv, 1024, 2048, (bf16_t*)(sm + SM_WXKV), 0, nullptr, nullptr, gw, nw, lane);
    transpose_w(p.w_xo, 1024, 1024, (bf16_t*)(sm + SM_WXO), 0, nullptr, nullptr, gw, nw, lane);
    transpose_w(p.w_up, 1024, 4096, (bf16_t*)(sm + SM_WUP), 4, p.ln2_g, nullptr, gw, nw, lane, 1.f);
    transpose_w(p.w_down, 4096, 1024, (bf16_t*)(sm + SM_WDOWN), 0, nullptr, nullptr, gw, nw, lane);
    { float* cp = (float*)(sm + SM_CP); const int gt0 = gw * 64 + lane, nt0 = nw * 64;
      for (int e = gt0; e < 16 * 5120; e += nt0) { const int ks = e / 5120, col = e - ks * 5120; const bool xq = col < 1024;
          const float* W = xq ? p.w_xq + col : p.w_up + (col - 1024); const int N = xq ? 1024 : 4096; const float csc = xq ? 0.0625f : 1.f;
          const float* gv = xq ? p.ln1_g : p.ln2_g; const float* bv = xq ? p.ln1_b : p.ln2_b; float a1 = 0.f, a2 = 0.f;
#pragma unroll 8
          for (int k = ks * 64; k < ks * 64 + 64; ++k) { const float w = W[(size_t)k * N] * csc; float x = w; x *= gv[k]; a1 += bf_lo(cvt_pk_bf16(x, 0.f)); a2 += bv[k] * w; }
          cp[ks * 5120 + col] = a1; cp[(16 + ks) * 5120 + col] = a2; } }
    { float* ss = (float*)(sm + SM_SMALL); const int gt0 = gw * 64 + lane, nt0 = nw * 64;
      for (int i = gt0; i < SS_TOTAL; i += nt0) { float v = 0.f;
          if (i < 3720) v = p.rpb[i]; else if (i >= SS_LN1G && i < SS_LN1G + 1024) v = p.ln1_g[i - SS_LN1G]; else if (i >= SS_LN1B && i < SS_LN1B + 1024) v = p.ln1_b[i - SS_LN1B];
          else if (i >= SS_LN2G && i < SS_LN2G + 1024) v = p.ln2_g[i - SS_LN2G]; else if (i >= SS_LN2B && i < SS_LN2B + 1024) v = p.ln2_b[i - SS_LN2B];
          ss[i] = v; } }
    { bf16_t* mb = (bf16_t*)(sm + SM_MEMB); const int gt = gw * 64 + lane, nt = nw * 64;
      for (int i = gt; i < NMEM * 1024 / 8; i += nt) { const int e = i * 8; const float* s = e < 4096 * 1024 ? p.mem_prompt + e : p.mem_sample + (e - 4096 * 1024);
          const f32x4 a = *(const f32x4*)s, b = *(const f32x4*)(s + 4); u32x4 w; w.x = cvt_pk_bf16(a[0], a[1]); w.y = cvt_pk_bf16(a[2], a[3]); w.z = cvt_pk_bf16(b[0], b[1]); w.w = cvt_pk_bf16(b[2], b[3]);
          *(u32x4*)(mb + e) = w; }
      float* rc = (float*)(sm + SM_RC); float* rs = (float*)(sm + SM_RS);
      for (int i = gt; i < 8192 * 32; i += nt) { const int t = i >> 5, f = i & 31; const float inv = powf(10000.0f, -(float)f / 32.0f); const float ang = (float)t * inv;
          const double a = (double)ang; const double kq = rint(a * 0.15915494309189535); const float r = (float)(a - kq * 6.283185307179586);
          rc[i] = cosf(r); rs[i] = sinf(r); } }
    bf16_t* XN = (bf16_t*)(p.ws + WS_XN);
    f32x4 g[4], b[4];
    g[0] = *(const f32x4*)(p.ln_in_g + lane * 8); g[1] = *(const f32x4*)(p.ln_in_g + lane * 8 + 4); g[2] = *(const f32x4*)(p.ln_in_g + 512 + lane * 8); g[3] = *(const f32x4*)(p.ln_in_g + 516 + lane * 8);
    b[0] = *(const f32x4*)(p.ln_in_b + lane * 8); b[1] = *(const f32x4*)(p.ln_in_b + lane * 8 + 4); b[2] = *(const f32x4*)(p.ln_in_b + 512 + lane * 8); b[3] = *(const f32x4*)(p.ln_in_b + 516 + lane * 8);
#pragma unroll 1
    for (int row = gw; row < MTOK; row += 2 * nw) {
        const int row2 = row + nw;
        const float* x = row < MP ? p.x_prompt + (size_t)row * 1024 : p.x_sample + (size_t)(row - MP) * 1024;
        const float* y = row2 < MP ? p.x_prompt + (size_t)row2 * 1024 : p.x_sample + (size_t)(row2 - MP) * 1024;
        const f32x4 v0 = *(const f32x4*)(x + lane * 8), v1 = *(const f32x4*)(x + lane * 8 + 4), v2 = *(const f32x4*)(x + 512 + lane * 8), v3 = *(const f32x4*)(x + 516 + lane * 8);
        const f32x4 u0 = *(const f32x4*)(y + lane * 8), u1 = *(const f32x4*)(y + lane * 8 + 4), u2 = *(const f32x4*)(y + 512 + lane * 8), u3 = *(const f32x4*)(y + 516 + lane * 8);
        float s1 = hsum((v0 + v1) + (v2 + v3)), q1 = hsum((v0 * v0 + v1 * v1) + (v2 * v2 + v3 * v3)), s2 = hsum((u0 + u1) + (u2 + u3)), q2 = hsum((u0 * u0 + u1 * u1) + (u2 * u2 + u3 * u3));
        wave_sum4(s1, q1, s2, q2);
        const float m1 = s1 * (1.f / 1024.f), m2 = s2 * (1.f / 1024.f);
        const float r1 = rsqrtf(fmaxf(q1 * (1.f / 1024.f) - m1 * m1, 0.f) + LN_EPS_C), r2 = rsqrtf(fmaxf(q2 * (1.f / 1024.f) - m2 * m2, 0.f) + LN_EPS_C);
        ln_store<false>(v0, v1, v2, v3, m1, r1, g, b, XN, nullptr, row, lane);
        ln_store<false>(u0, u1, u2, u3, m2, r2, g, b, XN, nullptr, row2, lane);
    }
}

template <bool OUTF32>
DI void phase_ln(const bf16_t* __restrict__ Z, const float* __restrict__ gam, const float* __restrict__ bet, bf16_t* __restrict__ X, float* __restrict__ OF, int gw, int nw, int lane) {
    f32x4 g[4], b[4];
    g[0] = *(const f32x4*)(gam + lane * 8); g[1] = *(const f32x4*)(gam + lane * 8 + 4); g[2] = *(const f32x4*)(gam + 512 + lane * 8); g[3] = *(const f32x4*)(gam + 516 + lane * 8);
    b[0] = *(const f32x4*)(bet + lane * 8); b[1] = *(const f32x4*)(bet + lane * 8 + 4); b[2] = *(const f32x4*)(bet + 512 + lane * 8); b[3] = *(const f32x4*)(bet + 516 + lane * 8);
#pragma unroll 1
    for (int rowi = gw; rowi < MTOK; rowi += 2 * nw) {
        const int row = OUTF32 ? MTOK - 1 - rowi : rowi, row2 = OUTF32 ? row - nw : row + nw;
        const u32x4 za = *(const u32x4*)(Z + (size_t)row * 1024 + lane * 8), zb = *(const u32x4*)(Z + (size_t)row * 1024 + 512 + lane * 8);
        const u32x4 zc = *(const u32x4*)(Z + (size_t)row2 * 1024 + lane * 8), zd = *(const u32x4*)(Z + (size_t)row2 * 1024 + 512 + lane * 8);
        const f32x4 v0 = (f32x4){bf_lo(za.x), bf_hi(za.x), bf_lo(za.y), bf_hi(za.y)}, v1 = (f32x4){bf_lo(za.z), bf_hi(za.z), bf_lo(za.w), bf_hi(za.w)};
        const f32x4 v2 = (f32x4){bf_lo(zb.x), bf_hi(zb.x), bf_lo(zb.y), bf_hi(zb.y)}, v3 = (f32x4){bf_lo(zb.z), bf_hi(zb.z), bf_lo(zb.w), bf_hi(zb.w)};
        const f32x4 u0 = (f32x4){bf_lo(zc.x), bf_hi(zc.x), bf_lo(zc.y), bf_hi(zc.y)}, u1 = (f32x4){bf_lo(zc.z), bf_hi(zc.z), bf_lo(zc.w), bf_hi(zc.w)};
        const f32x4 u2 = (f32x4){bf_lo(zd.x), bf_hi(zd.x), bf_lo(zd.y), bf_hi(zd.y)}, u3 = (f32x4){bf_lo(zd.z), bf_hi(zd.z), bf_lo(zd.w), bf_hi(zd.w)};
        float s1 = hsum((v0 + v1) + (v2 + v3)), q1 = hsum((v0 * v0 + v1 * v1) + (v2 * v2 + v3 * v3)), s2 = hsum((u0 + u1) + (u2 + u3)), q2 = hsum((u0 * u0 + u1 * u1) + (u2 * u2 + u3 * u3));
        wave_sum4(s1, q1, s2, q2);
        const float m1 = s1 * (1.f / 1024.f), m2 = s2 * (1.f / 1024.f);
        const float r1 = rsqrtf(fmaxf(q1 * (1.f / 1024.f) - m1 * m1, 0.f) + LN_EPS_C), r2 = rsqrtf(fmaxf(q2 * (1.f / 1024.f) - m2 * m2, 0.f) + LN_EPS_C);
        ln_store<OUTF32>(v0, v1, v2, v3, m1, r1, g, b, X, OF, row, lane);
        ln_store<OUTF32>(u0, u1, u2, u3, m2, r2, g, b, X, OF, row2, lane);
    }
}

constexpr int VROW = 144;
constexpr int VWAVE = 64 * VROW;
constexpr int LDS_RMS = 8 * VWAVE;
constexpr int LDS_RPB = LDS_RMS + 4096;

DI void tr_read8(unsigned addr, s16x4 (&r)[8]) {
    asm volatile("s_waitcnt lgkmcnt(0)\n\t"
                 "ds_read_b64_tr_b16 %0, %8 offset:0\n\t" "ds_read_b64_tr_b16 %1, %8 offset:2304\n\t"
                 "ds_read_b64_tr_b16 %2, %8 offset:32\n\t" "ds_read_b64_tr_b16 %3, %8 offset:2336\n\t"
                 "ds_read_b64_tr_b16 %4, %8 offset:64\n\t" "ds_read_b64_tr_b16 %5, %8 offset:2368\n\t"
                 "ds_read_b64_tr_b16 %6, %8 offset:96\n\t" "ds_read_b64_tr_b16 %7, %8 offset:2400\n\t"
                 "s_waitcnt lgkmcnt(0)"
                 : "=&v"(r[0]), "=&v"(r[1]), "=&v"(r[2]), "=&v"(r[3]), "=&v"(r[4]), "=&v"(r[5]), "=&v"(r[6]), "=&v"(r[7]) : "v"(addr) : "memory");
}

template <int NO>
DI void softmax_chunk(f32x4 (&s)[4], float& m, float& l, f32x4 (&o)[NO], bf16x8 (&pf)[2]) {
    float mx = fmaxf(fmaxf(fmaxf(s[0][0], s[0][1]), fmaxf(s[0][2], s[0][3])), fmaxf(fmaxf(s[1][0], s[1][1]), fmaxf(s[1][2], s[1][3])));
    mx = fmaxf(mx, fmaxf(fmaxf(fmaxf(s[2][0], s[2][1]), fmaxf(s[2][2], s[2][3])), fmaxf(fmaxf(s[3][0], s[3][1]), fmaxf(s[3][2], s[3][3]))));
    if (__builtin_amdgcn_ballot_w64(mx > m + 16.f)) {
        mx = fmaxf(mx, __shfl_xor(mx, 16)); mx = fmaxf(mx, __shfl_xor(mx, 32));
        const float mn = fmaxf(m, mx), alpha = __builtin_amdgcn_exp2f((m - mn) * LOG2E_C); m = mn; l *= alpha;
#pragma unroll
        for (int c = 0; c < NO; ++c) o[c] *= alpha;
    }
    const float nb = -m * LOG2E_C;
    float ps = 0.f;
#pragma unroll
    for (int kt = 0; kt < 4; ++kt)
#pragma unroll
        for (int e = 0; e < 4; ++e) { const float pv = __builtin_amdgcn_exp2f(s[kt][e] * LOG2E_C + nb); s[kt][e] = pv; ps += pv; }
    l += ps;
#pragma unroll
    for (int pr = 0; pr < 2; ++pr) { u32x4 w; w.x = cvt_pk_bf16(s[2 * pr][0], s[2 * pr][1]); w.y = cvt_pk_bf16(s[2 * pr][2], s[2 * pr][3]);
        w.z = cvt_pk_bf16(s[2 * pr + 1][0], s[2 * pr + 1][1]); w.w = cvt_pk_bf16(s[2 * pr + 1][2], s[2 * pr + 1][3]); pf[pr] = __builtin_bit_cast(bf16x8, w); }
}

template <int NCH, class KOff, class VOff, class Score>
DI void attn64_run(const char* __restrict__ qkvb, const bf16x8 q0, const bf16x8 q1, unsigned char* vl, int lane, f32x4 (&o)[4], float& m, float& l, KOff koff, VOff voff, Score score) {
    const int fr = lane & 15, fq = lane >> 4;
    const unsigned vaddr = (unsigned)(size_t)vl + (unsigned)((4 * fq + (fr >> 2)) * VROW + (fr & 3) * 8);
    unsigned char* vw = vl + (lane >> 3) * VROW + (lane & 7) * 16;
    const unsigned char* krd = vl + fr * VROW + fq * 16;
    u32x4 kr[8], vr[8];
#pragma unroll
    for (int it = 0; it < 8; ++it) kr[it] = *(const u32x4*)(qkvb + koff(0, it));
#pragma unroll
    for (int it = 0; it < 8; ++it) vr[it] = *(const u32x4*)(qkvb + voff(0, it));
#pragma unroll 1
    for (int c = 0; c < NCH; ++c) {
        u32x4 vc[8];
#pragma unroll
        for (int it = 0; it < 8; ++it) *(u32x4*)(vw + it * 8 * VROW) = kr[it];
#pragma unroll
        for (int it = 0; it < 8; ++it) vc[it] = vr[it];
        __builtin_amdgcn_fence(__ATOMIC_RELEASE, "wavefront");
        bf16x8 kc[4][2];
#pragma unroll
        for (int kt = 0; kt < 4; ++kt) { kc[kt][0] = *(const bf16x8*)(krd + kt * 16 * VROW); kc[kt][1] = *(const bf16x8*)(krd + kt * 16 * VROW + 64); }
        if (c + 1 < NCH) {
#pragma unroll
            for (int it = 0; it < 8; ++it) kr[it] = *(const u32x4*)(qkvb + koff(c + 1, it));
#pragma unroll
            for (int it = 0; it < 8; ++it) vr[it] = *(const u32x4*)(qkvb + voff(c + 1, it));
        }
        f32x4 s[4];
#pragma unroll
        for (int kt = 0; kt < 4; ++kt) { s[kt] = __builtin_amdgcn_mfma_f32_16x16x32_bf16(kc[kt][0], q0, (f32x4){0.f, 0.f, 0.f, 0.f}, 0, 0, 0); s[kt] = __builtin_amdgcn_mfma_f32_16x16x32_bf16(kc[kt][1], q1, s[kt], 0, 0, 0); }
#pragma unroll
        for (int kt = 0; kt < 4; ++kt)
#pragma unroll
            for (int e = 0; e < 4; ++e) s[kt][e] = score(c, s[kt][e], kt, e);
        bf16x8 pf[2];
        softmax_chunk<4>(s, m, l, o, pf);
#pragma unroll
        for (int it = 0; it < 8; ++it) *(u32x4*)(vw + it * 8 * VROW) = vc[it];
#pragma unroll
        for (int pr = 0; pr < 2; ++pr) { s16x4 t[8]; tr_read8(vaddr + pr * 32 * VROW, t);
#pragma unroll
            for (int dc = 0; dc < 4; ++dc) { const bf16x8 vf = __builtin_shufflevector(t[2 * dc], t[2 * dc + 1], 0, 1, 2, 3, 4, 5, 6, 7); o[dc] = __builtin_amdgcn_mfma_f32_16x16x32_bf16(vf, pf[pr], o[dc], 0, 0, 0); } }
    }
}

template <int NO>
DI void softmax_pair(f32x4& s0, f32x4& s1, float& m, float& l, f32x4 (&o)[NO], bf16x8& pf) {
    float mx = fmaxf(fmaxf(fmaxf(s0[0], s0[1]), fmaxf(s0[2], s0[3])), fmaxf(fmaxf(s1[0], s1[1]), fmaxf(s1[2], s1[3])));
    if (__builtin_amdgcn_ballot_w64(mx > m + 16.f)) {
        mx = fmaxf(mx, __shfl_xor(mx, 16)); mx = fmaxf(mx, __shfl_xor(mx, 32));
        const float mn = fmaxf(m, mx), alpha = __builtin_amdgcn_exp2f((m - mn) * LOG2E_C); m = mn; l *= alpha;
#pragma unroll
        for (int c = 0; c < NO; ++c) o[c] *= alpha;
    }
    const float nb = -m * LOG2E_C;
    float ps = 0.f;
#pragma unroll
    for (int e = 0; e < 4; ++e) { s0[e] = __builtin_amdgcn_exp2f(s0[e] * LOG2E_C + nb); s1[e] = __builtin_amdgcn_exp2f(s1[e] * LOG2E_C + nb); ps += s0[e] + s1[e]; }
    l += ps;
    u32x4 w; w.x = cvt_pk_bf16(s0[0], s0[1]); w.y = cvt_pk_bf16(s0[2], s0[3]); w.z = cvt_pk_bf16(s1[0], s1[1]); w.w = cvt_pk_bf16(s1[2], s1[3]); pf = __builtin_bit_cast(bf16x8, w);
}
template <int NG, class KOff, class VOff, class Score, class Use, class Full>
DI void attn_mg_run(const int nimg, const char* __restrict__ qkvb, unsigned char* vl, int lane, f32x4 (&o)[NG][4], float (&m)[NG], float (&l)[NG], const bf16x8 (&q0)[NG], const bf16x8 (&q1)[NG],
                    KOff koff, VOff voff, Score score, Use use, Full full) {
    const int fr = lane & 15, fq = lane >> 4;
    const unsigned vaddr = (unsigned)(size_t)vl + (unsigned)(32 * VROW + (4 * fq + (fr >> 2)) * VROW + (fr & 3) * 8);
    unsigned char* vw = vl + (lane >> 3) * VROW + (lane & 7) * 16;
    const unsigned char* krd = vl + fr * VROW + fq * 16;
    u32x4 kr[4], vr[4];
#pragma unroll
    for (int j = 0; j < 4; ++j) { kr[j] = *(const u32x4*)(qkvb + koff(0, j)); vr[j] = *(const u32x4*)(qkvb + voff(0, j)); }
#pragma unroll 1
    for (int i = 0; i < nimg; ++i) {
#pragma unroll
        for (int j = 0; j < 4; ++j) { *(u32x4*)(vw + j * 8 * VROW) = kr[j]; *(u32x4*)(vw + (32 + j * 8) * VROW) = vr[j]; }
        __builtin_amdgcn_fence(__ATOMIC_RELEASE, "wavefront");
        bf16x8 kc[2][2];
#pragma unroll
        for (int kt = 0; kt < 2; ++kt) { kc[kt][0] = *(const bf16x8*)(krd + kt * 16 * VROW); kc[kt][1] = *(const bf16x8*)(krd + kt * 16 * VROW + 64); }
        if (i + 1 < nimg) {
#pragma unroll
            for (int j = 0; j < 4; ++j) { kr[j] = *(const u32x4*)(qkvb + koff(i + 1, j)); vr[j] = *(const u32x4*)(qkvb + voff(i + 1, j)); }
        }
        bf16x8 pf[NG];
#pragma unroll
        for (int g = 0; g < NG; ++g) {
            if (use(i, g)) {
                f32x4 s0 = __builtin_amdgcn_mfma_f32_16x16x32_bf16(kc[0][0], q0[g], (f32x4){0.f, 0.f, 0.f, 0.f}, 0, 0, 0); s0 = __builtin_amdgcn_mfma_f32_16x16x32_bf16(kc[0][1], q1[g], s0, 0, 0, 0);
                f32x4 s1 = __builtin_amdgcn_mfma_f32_16x16x32_bf16(kc[1][0], q0[g], (f32x4){0.f, 0.f, 0.f, 0.f}, 0, 0, 0); s1 = __builtin_amdgcn_mfma_f32_16x16x32_bf16(kc[1][1], q1[g], s1, 0, 0, 0);
                if (!full(i, g)) {
#pragma unroll
                    for (int e = 0; e < 4; ++e) { s0[e] = score(i, g, s0[e], 0, e); s1[e] = score(i, g, s1[e], 1, e); } }
                softmax_pair<4>(s0, s1, m[g], l[g], o[g], pf[g]);
            }
        }
        s16x4 t[8]; tr_read8(vaddr, t);
        bf16x8 vf[4];
#pragma unroll
        for (int dc = 0; dc < 4; ++dc) vf[dc] = __builtin_shufflevector(t[2 * dc], t[2 * dc + 1], 0, 1, 2, 3, 4, 5, 6, 7);
#pragma unroll
        for (int g = 0; g < NG; ++g) {
            if (use(i, g)) {
#pragma unroll
                for (int dc = 0; dc < 4; ++dc) o[g][dc] = __builtin_amdgcn_mfma_f32_16x16x32_bf16(vf[dc], pf[g], o[g][dc], 0, 0, 0);
            }
        }
    }
}

DI void attn64_finish(f32x4 (&o)[4], float l, float* rms, int& par, int wid, int lane, bf16_t* __restrict__ dst  ) {
    const int fr = lane & 15, fq = lane >> 4;
    l += __shfl_xor(l, 16); l += __shfl_xor(l, 32);
    const float inv = 1.0f / l; float ss = 0.f;
#pragma unroll
    for (int c = 0; c < 4; ++c) { o[c] *= inv; ss += (o[c][0] * o[c][0] + o[c][1] * o[c][1]) + (o[c][2] * o[c][2] + o[c][3] * o[c][3]); }
    ss += __shfl_xor(ss, 16); ss += __shfl_xor(ss, 32);
    float* rb = rms + par * 128;
    if (fq == 0) rb[wid * 16 + fr] = ss;
    __syncthreads();
    float tot = 0.f;
#pragma unroll
    for (int w = 0; w < 8; ++w) tot += rb[w * 16 + fr];
    const float rstd = rsqrtf(tot * (1.f / 512.f) + LN_EPS_C);
#pragma unroll
    for (int c = 0; c < 4; ++c) { u32x2 w; w.x = cvt_pk_bf16(o[c][0] * rstd, o[c][1] * rstd); w.y = cvt_pk_bf16(o[c][2] * rstd, o[c][3] * rstd); *(u32x2*)(dst + 16 * c + 4 * fq) = w; }
    par ^= 1;
}

template <class Dst>
DI void attn64_finish4(f32x4 (&o)[4][4], float (&l)[4], float* rms, int& par, int wid, int lane, Dst dst) {
    const int fr = lane & 15, fq = lane >> 4;
    float* rb = rms + par * 512;
#pragma unroll
    for (int g = 0; g < 4; ++g) { float lt = l[g]; lt += __shfl_xor(lt, 16); lt += __shfl_xor(lt, 32);
        const float inv = 1.0f / lt; float ss = 0.f;
#pragma unroll
        for (int c = 0; c < 4; ++c) { o[g][c] *= inv; ss += (o[g][c][0] * o[g][c][0] + o[g][c][1] * o[g][c][1]) + (o[g][c][2] * o[g][c][2] + o[g][c][3] * o[g][c][3]); }
        ss += __shfl_xor(ss, 16); ss += __shfl_xor(ss, 32);
        if (fq == 0) rb[g * 128 + wid * 16 + fr] = ss; }
    __syncthreads();
#pragma unroll
    for (int g = 0; g < 4; ++g) { float tot = 0.f;
#pragma unroll
        for (int w = 0; w < 8; ++w) tot += rb[g * 128 + w * 16 + fr];
        const float rstd = rsqrtf(tot * (1.f / 512.f) + LN_EPS_C); bf16_t* d = dst(g);
#pragma unroll
        for (int c = 0; c < 4; ++c) { u32x2 w; w.x = cvt_pk_bf16(o[g][c][0] * rstd, o[g][c][1] * rstd); w.y = cvt_pk_bf16(o[g][c][2] * rstd, o[g][c][3] * rstd); *(u32x2*)(d + 16 * c + 4 * fq) = w; } }
    par ^= 1;
}

DI void phase_attn(const Params& p, unsigned char* shm, int wid, int lane, int vcu) {
    const bf16_t* QKV = (const bf16_t*)(p.ws + WS_QKV); bf16_t* O = (bf16_t*)(p.out + OUT_O); const char* qkvb = (const char*)QKV;
    const int fr = lane & 15, fq = lane >> 4, h = wid, l3 = lane >> 3, l7 = lane & 7;
    unsigned char* vl = shm + wid * VWAVE; float* rms = (float*)(shm + LDS_RMS); float* rpbs = (float*)(shm + LDS_RPB);
    for (int i = threadIdx.x; i < 8 * 465 + 192; i += 512) rpbs[i] = (i >= 96 && i < 96 + 8 * 465) ? ((const float*)(p.out + SM_SMALL))[SS_RPB + i - 96] : 0.f;
    __syncthreads();
    int par = 0;
    float* ML = (float*)(p.out + SM_ML);
    for (int item = vcu; item < MTOK / 256; item += gridDim.x) {
        const int row_base = item * 256; const int T_ = row_base < MP ? 4096 : 8192; const int bb_ = row_base < MP ? (row_base & ~4095) : MP + ((row_base - MP) & ~8191); const int t0_ = row_base - bb_;
        const unsigned kcolb = (unsigned)(512 + h * 64) * 2u + 16u * l7, vcolb = (unsigned)(1024 + h * 64) * 2u + 16u * l7;
#pragma unroll 1
        for (int blk = 0; blk < (NO_P1 ? 0 : 4); ++blk) {
            int t0 = t0_, bb = bb_, T = T_; asm volatile("" : "+s"(t0), "+s"(bb), "+s"(T));
            const int tb = t0 + 64 * blk, kb = tb - 64;
            f32x4 o[4][4]; float m[4], l[4]; bf16x8 q0[4], q1[4];
#pragma unroll
            for (int g = 0; g < 4; ++g) { const bf16_t* qp = QKV + (size_t)(bb + tb + 16 * g + fr) * 3072 + h * 64 + 8 * fq; q0[g] = *(const bf16x8*)qp; q1[g] = *(const bf16x8*)(qp + 32); m[g] = -1e30f; l[g] = 0.f;
#pragma unroll
                for (int c = 0; c < 4; ++c) o[g][c] = (f32x4){0.f, 0.f, 0.f, 0.f}; }
            auto koff = [&](int i, int j) -> unsigned { int jj = kb + 32 * i + 8 * j + l3; jj = jj < 0 ? 0 : (jj > T - 1 ? T - 1 : jj); return (unsigned)(bb + jj) * 6144u + kcolb; };
            auto voff = [&](int i, int j) -> unsigned { int jj = kb + 32 * i + 8 * j + l3; jj = jj < 0 ? 0 : (jj > T - 1 ? T - 1 : jj); return (unsigned)(bb + jj) * 6144u + vcolb; };
            auto score = [&](int i, int g, float sv, int kt, int e) -> float { const int jq = tb + 16 * g + fr, lo = jq - 64 < 0 ? 0 : jq - 64, hi = jq + 64 > T - 1 ? T - 1 : jq + 64;
                const int base = kb + 32 * i + 4 * fq - lo; return ((unsigned)(base + 16 * kt + e) <= (unsigned)(hi - lo)) ? sv : -INFINITY; };
            auto use = [&](int i, int g) -> bool { return !((i == 5 && g < 2) || (i == 0 && g >= 2)); };
            auto full = [&](int i, int g) -> bool { return false; };
            attn_mg_run<4>(6, qkvb, vl, lane, o, m, l, q0, q1, koff, voff, score, use, full);
#pragma unroll
            for (int g = 0; g < 4; ++g) { float lt = l[g]; lt += __shfl_xor(lt, 16); lt += __shfl_xor(lt, 32);
                const size_t qrow = (size_t)(bb + tb + 16 * g + fr); const float inv = 1.0f / lt; bf16_t* dst = O + qrow * 1024 + h * 64 + 4 * fq;
#pragma unroll
                for (int c = 0; c < 4; ++c) { u32x2 w; w.x = cvt_pk_bf16(o[g][c][0] * inv, o[g][c][1] * inv); w.y = cvt_pk_bf16(o[g][c][2] * inv, o[g][c][3] * inv); *(u32x2*)(dst + 16 * c) = w; }
                if (fq == 0) { float2 ml; ml.x = m[g]; ml.y = lt; *(float2*)(ML + (qrow * 8 + h) * 2) = ml; } }
        }
    }
    __syncthreads();
    for (int item = vcu; item < MTOK / 256; item += gridDim.x) {
        const int row_base = item * 256; const int T_ = row_base < MP ? 4096 : 8192; const int bb_ = row_base < MP ? (row_base & ~4095) : MP + ((row_base - MP) & ~8191); const int t0_ = row_base - bb_;
        const unsigned kcolb = (unsigned)(512 + h * 64) * 2u + 16u * l7, vcolb = (unsigned)(1024 + h * 64) * 2u + 16u * l7;
#pragma unroll 1
        for (int r4 = 0; r4 < (NO_P2 ? 0 : 4); ++r4) { const int ah = 0;
            int t0 = t0_, bb = bb_, T = T_; asm volatile("" : "+s"(t0), "+s"(bb), "+s"(T));
            f32x4 o[4][4]; float m[4], l[4]; bf16x8 q0[4], q1[4];
#pragma unroll
            for (int a = 0; a < 4; ++a) { const size_t qrow = (size_t)(bb + t0 + r4 + 4 * (ah + a) + 16 * fr);
                const bf16_t* qp = QKV + qrow * 3072 + h * 64 + 8 * fq; q0[a] = *(const bf16x8*)qp; q1[a] = *(const bf16x8*)(qp + 32);
                const float2 ml = *(const float2*)(ML + (qrow * 8 + h) * 2); m[a] = ml.x; l[a] = fq == 0 ? ml.y : 0.f; const bf16_t* src = O + qrow * 1024 + h * 64 + 4 * fq;
#pragma unroll
                for (int c = 0; c < 4; ++c) { const u32x2 w = *(const u32x2*)(src + 16 * c); o[a][c] = (f32x4){bf_lo(w.x) * ml.y, bf_hi(w.x) * ml.y, bf_lo(w.y) * ml.y, bf_hi(w.y) * ml.y}; } }
            {
                const int L = T >> 2, kb = (t0 >> 2) - 64;
                auto koff = [&](int i, int j) -> unsigned { int jj = kb + 32 * i + 8 * j + l3; jj = jj < 0 ? 0 : (jj > L - 1 ? L - 1 : jj); return (unsigned)(bb + 4 * jj + r4) * 6144u + kcolb; };
                auto voff = [&](int i, int j) -> unsigned { int jj = kb + 32 * i + 8 * j + l3; jj = jj < 0 ? 0 : (jj > L - 1 ? L - 1 : jj); return (unsigned)(bb + 4 * jj + r4) * 6144u + vcolb; };
                auto score = [&](int i, int g, float sv, int kt, int e) -> float { const int jq = (t0 >> 2) + ah + g + 4 * fr, lo = jq - 64 < 0 ? 0 : jq - 64, hi = jq + 64 > L - 1 ? L - 1 : jq + 64;
                    const int base = kb + 32 * i + 4 * fq - lo; return ((unsigned)(base + 16 * kt + e) <= (unsigned)(hi - lo)) ? sv : -INFINITY; };
                auto use = [&](int i, int g) -> bool { return true; };
                auto full = [&](int i, int g) -> bool { return false; };
                attn_mg_run<4>(6, qkvb, vl, lane, o, m, l, q0, q1, koff, voff, score, use, full);
            }
#pragma unroll
            for (int a = 0; a < 4; ++a) {
                const int r = r4 + 4 * (ah + a), L = T >> 4, kb = (t0 >> 4) - 64;
                f32x4 (&o1)[1][4] = *reinterpret_cast<f32x4 (*)[1][4]>(&o[a]); float (&m1)[1] = *reinterpret_cast<float (*)[1]>(&m[a]); float (&l1)[1] = *reinterpret_cast<float (*)[1]>(&l[a]);
                const bf16x8 (&qa)[1] = *reinterpret_cast<const bf16x8 (*)[1]>(&q0[a]); const bf16x8 (&qb)[1] = *reinterpret_cast<const bf16x8 (*)[1]>(&q1[a]);
                auto koff = [&](int i, int j) -> unsigned { int jj = kb + 32 * i + 8 * j + l3; jj = jj < 0 ? 0 : (jj > L - 1 ? L - 1 : jj); return (unsigned)(bb + 16 * jj + r) * 6144u + kcolb; };
                auto voff = [&](int i, int j) -> unsigned { int jj = kb + 32 * i + 8 * j + l3; jj = jj < 0 ? 0 : (jj > L - 1 ? L - 1 : jj); return (unsigned)(bb + 16 * jj + r) * 6144u + vcolb; };
                auto score = [&](int i, int g, float sv, int kt, int e) -> float { const int jq = (t0 >> 4) + fr, lo = jq - 64 < 0 ? 0 : jq - 64, hi = jq + 64 > L - 1 ? L - 1 : jq + 64;
                    const int base = kb + 32 * i + 4 * fq - lo; return ((unsigned)(base + 16 * kt + e) <= (unsigned)(hi - lo)) ? sv : -INFINITY; };
                auto use = [&](int i, int g) -> bool { return true; };
                auto full = [&](int i, int g) -> bool { return false; };
                attn_mg_run<1>(5, qkvb, vl, lane, o1, m1, l1, qa, qb, koff, voff, score, use, full);
            }
            attn64_finish4(o, l, rms, par, wid, lane, [&](int a) -> bf16_t* { return O + (size_t)(bb + t0 + r4 + 4 * a + 16 * fr) * 1024 + h * 64; });
        }
    }
    for (int item = vcu; item < MTOK / 64; item += gridDim.x) {
        const int row_base = item * 64; const int T = row_base < MP ? 4096 : 8192; const int bb = row_base < MP ? (row_base & ~4095) : MP + ((row_base - MP) & ~8191);
        const int rows = T >> 6, rq = (row_base - bb) >> 6; int rs = rq - 4; rs = rs < 0 ? 0 : (rs > rows - 8 ? rows - 8 : rs);
        const unsigned kcolb = (unsigned)(2048 + h * 64) * 2u + 16u * l7, vcolb = (unsigned)(2560 + h * 64) * 2u + 16u * l7;
        f32x4 o[4][4]; float m[4], l[4]; bf16x8 q0[4], q1[4];
#pragma unroll
        for (int g = 0; g < 4; ++g) { const bf16_t* qp = QKV + (size_t)(row_base + 16 * g + fr) * 3072 + 1536 + h * 64 + 8 * fq; q0[g] = *(const bf16x8*)qp; q1[g] = *(const bf16x8*)(qp + 32); m[g] = -1e30f; l[g] = 0.f;
#pragma unroll
            for (int c = 0; c < 4; ++c) o[g][c] = (f32x4){0.f, 0.f, 0.f, 0.f}; }
        const unsigned kb0 = (unsigned)(bb + rs * 64 + l3) * 6144u;
        const float* bl = rpbs + 96 + h * 465 + 15 + (rs - rq + 7) * 31 + 4 * fq - fr;
        const int rsm = rs & 7;
        auto koff = [&](int i, int j) -> unsigned { const int a = ((i >> 1) + 8 - rsm) & 7; return kb0 + (unsigned)(a * 64 + 32 * (i & 1) + 8 * j) * 6144u + kcolb; };
        auto voff = [&](int i, int j) -> unsigned { const int a = ((i >> 1) + 8 - rsm) & 7; return kb0 + (unsigned)(a * 64 + 32 * (i & 1) + 8 * j) * 6144u + vcolb; };
        auto score = [&](int i, int g, float sv, int kt, int e) -> float { const int qc = 16 * g + fr; int cs = qc - 8; cs = cs < 0 ? 0 : (cs > 48 ? 48 : cs);
            const float bias = bl[(((i >> 1) + 8 - rsm) & 7) * 31 + 32 * (i & 1) + 16 * kt + e - 16 * g];
            return ((unsigned)(32 * (i & 1) + 4 * fq - cs + 16 * kt + e) < 16u) ? sv + bias : -INFINITY; };
        auto use = [&](int i, int g) -> bool { return (i & 1) ? (g > 0) : (g < 3); };
        auto full = [&](int i, int g) -> bool { return false; };
        attn_mg_run<4>(16, qkvb, vl, lane, o, m, l, q0, q1, koff, voff, score, use, full);
        attn64_finish4(o, l, rms, par, wid, lane, [&](int g) -> bf16_t* { return O + (size_t)(row_base + 16 * g + fr) * 1024 + 512 + h * 64; });
    }
    __syncthreads();
}

constexpr int XK_PITCH = 528, XV_PITCH = 144, XK_BYTES = 64 * XK_PITCH, XV_BYTES = 256 * XV_PITCH;
DI void x_gload(const bf16_t* __restrict__ KM, const bf16_t* __restrict__ VTM, int bitem, int c, int tid, u32x4 (&r)[8]) {
    const int rb = bitem >> 2, h = bitem & 3, row0 = rb * 128; const int gb = row0 < MP ? (row0 >> 12) : 16 + ((row0 - MP) >> 13);
#pragma unroll
    for (int j = 0; j < 4; ++j) { const int q = tid + 512 * j; r[j] = *(const u32x4*)(KM + (size_t)(gb * 256 + 64 * c + (q >> 5)) * 1024 + h * 256 + (q & 31) * 8); }
#pragma unroll
    for (int j = 0; j < 4; ++j) { const int q = tid + 512 * j; r[4 + j] = *(const u32x4*)(VTM + (size_t)(h * 256 + (q >> 3)) * NMEM + gb * 256 + 64 * c + (q & 7) * 8); }
}
DI void x_lstore(unsigned char* kl, unsigned char* vl, int tid, const u32x4 (&r)[8]) {
#pragma unroll
    for (int j = 0; j < 4; ++j) { const int q = tid + 512 * j; *(u32x4*)(kl + (q >> 5) * XK_PITCH + (q & 31) * 16) = r[j]; }
#pragma unroll
    for (int j = 0; j < 4; ++j) { const int q = tid + 512 * j; *(u32x4*)(vl + (q >> 3) * XV_PITCH + (q & 7) * 16) = r[4 + j]; }
}
constexpr int XBUF = XK_BYTES + XV_BYTES;
DI void phase_xattn(const Params& p, unsigned char* shm, int wid, int lane) {
    const bf16_t* QX = (const bf16_t*)(p.ws + WS_QX); const bf16_t* KM = (const bf16_t*)(p.out + SM_KM); const bf16_t* VTM = (const bf16_t*)(p.out + SM_VTM); bf16_t* OC = (bf16_t*)(p.ws + WS_OC);
    const int fr = lane & 15, fq = lane >> 4, tid = threadIdx.x, G = gridDim.x;
    constexpr int NIT = (MTOK / 128) * 4;
    int bitem = blockIdx.x, step = 0;
    if (bitem < NIT) { u32x4 pre[8]; x_gload(KM, VTM, NIT - 1 - bitem, 0, tid, pre); x_lstore(shm, shm + XK_BYTES, tid, pre); }
    while (bitem < NIT) {
        const int ritem = NIT - 1 - bitem; const int rb = ritem >> 2, h = ritem & 3, row0 = rb * 128 + wid * 16;
        const bf16_t* qp = QX + (size_t)(row0 + fr) * 1024 + h * 256 + 8 * fq;
        bf16x8 qf[8];
#pragma unroll
        for (int ks = 0; ks < 8; ++ks) qf[ks] = *(const bf16x8*)(qp + 32 * ks);
        f32x4 o[16];
#pragma unroll
        for (int dc = 0; dc < 16; ++dc) o[dc] = (f32x4){0.f, 0.f, 0.f, 0.f};
        float m = -1e30f, l = 0.f;
#pragma unroll 1
        for (int c = 0; c < 4; ++c, ++step) {
            unsigned char* kl = shm + (step & 1) * XBUF; unsigned char* vl = kl + XK_BYTES;
            unsigned char* kn = shm + ((step & 1) ^ 1) * XBUF;
            const unsigned char* krd = kl + fr * XK_PITCH + fq * 16;
            const unsigned char* vrd = vl + fr * XV_PITCH + fq * 8;
            __syncthreads();
            const int nb = c < 3 ? bitem : bitem + G, nc = c < 3 ? c + 1 : 0; const bool has_next = nb < NIT;
            u32x4 pre[8];
            if (has_next) x_gload(KM, VTM, NIT - 1 - nb, nc, tid, pre);
            f32x4 s[4];
#pragma unroll
            for (int kt = 0; kt < 4; ++kt) { s[kt] = (f32x4){0.f, 0.f, 0.f, 0.f};
#pragma unroll
                for (int ks = 0; ks < 8; ++ks) { const bf16x8 kf = *(const bf16x8*)(krd + kt * 16 * XK_PITCH + ks * 64); s[kt] = __builtin_amdgcn_mfma_f32_16x16x32_bf16(kf, qf[ks], s[kt], 0, 0, 0); } }
            bf16x8 pf[2];
            softmax_chunk<16>(s, m, l, o, pf);
#pragma unroll
            for (int pr = 0; pr < 2; ++pr)
#pragma unroll
                for (int dc = 0; dc < 16; ++dc) { const unsigned char* vp = vrd + dc * 16 * XV_PITCH + pr * 64; const s16x4 lo = *(const s16x4*)vp, hi = *(const s16x4*)(vp + 32);
                    const bf16x8 vf = __builtin_shufflevector(lo, hi, 0, 1, 2, 3, 4, 5, 6, 7); o[dc] = __builtin_amdgcn_mfma_f32_16x16x32_bf16(vf, pf[pr], o[dc], 0, 0, 0); }
            if (has_next) x_lstore(kn, kn + XK_BYTES, tid, pre);
        }
        l += __shfl_xor(l, 16); l += __shfl_xor(l, 32);
        const float inv = 1.0f / l; bf16_t* dst = OC + (size_t)(row0 + fr) * 1024 + h * 256 + 4 * fq;
#pragma unroll
        for (int dc = 0; dc < 16; ++dc) { u32x2 w; w.x = cvt_pk_bf16(o[dc][0] * inv, o[dc][1] * inv); w.y = cvt_pk_bf16(o[dc][2] * inv, o[dc][3] * inv); *(u32x2*)(dst + 16 * dc) = w; }
        bitem += G;
    }
    __syncthreads();
}

#define XB_TMO      128
#define XB_XCNT(j)  (256  + 64 * (j))
#define XB_XSUB(j)  (1280 + 64 * (j))
#define XB_XGEN(j)  (2304 + 64 * (j))
#define XB_TOP      3328
#define XB_TOPGEN   3392
#define XCD_BAR_WORDS 3456
#define XB_SPIN_CAP (1u << 18)
__device__ __forceinline__ unsigned xb_ld(unsigned* p)              { return __hip_atomic_load(p, __ATOMIC_RELAXED, __HIP_MEMORY_SCOPE_AGENT); }
__device__ __forceinline__ unsigned xb_add(unsigned* p, unsigned v) { return __hip_atomic_fetch_add(p, v, __ATOMIC_RELAXED, __HIP_MEMORY_SCOPE_AGENT); }
__device__ __forceinline__ unsigned xb_xcc_id() { return (unsigned)__builtin_amdgcn_s_getreg((3 << 11) | 20) & 0xFu; }
#define XB_SPIN(cond, bar) do { unsigned _sp = 0; while (cond) { __builtin_amdgcn_s_sleep(1); \
    if ((++_sp & 255u) == 0u) { if (xb_ld(&(bar)[XB_TMO])) break; if (_sp > XB_SPIN_CAP) { atomicAdd(&(bar)[XB_TMO], 1u); break; } } } } while (0)
struct XcdBarrier { unsigned* bar; unsigned x; volatile PG8_LAS unsigned* st; };
__device__ __forceinline__ XcdBarrier xcd_barrier_post(unsigned* bar, volatile PG8_LAS unsigned* st) {
    XcdBarrier b; b.bar = bar; b.x = xb_xcc_id(); b.st = st;
    if (threadIdx.x == 0) (void)xb_add(&bar[XB_XCNT(b.x)], 1u);
    return b;
}
__device__ __forceinline__ void xcd_barrier_complete(unsigned* bar, unsigned x, unsigned& nloc, unsigned& nx) {
    const unsigned G = gridDim.x * gridDim.y * gridDim.z;
    unsigned sum, cnt, mine, sp = 0u;
    for (;;) {
        sum = 0u; cnt = 0u; mine = 0u;
#pragma unroll
        for (unsigned j = 0; j < 16; ++j) { const unsigned c = xb_ld(&bar[XB_XCNT(j)]); sum += c; cnt += (c > 0u) ? 1u : 0u; mine = (j == x) ? c : mine; }
        if (sum == G) break;
        __builtin_amdgcn_s_sleep(1);
        if ((++sp & 255u) == 0u) { if (xb_ld(&bar[XB_TMO])) break; if (sp > XB_SPIN_CAP) { atomicAdd(&bar[XB_TMO], 1u); break; } }
    }
    nloc = mine > 0u ? mine : 1u; nx = cnt > 0u ? cnt : 1u;
}
__device__ __forceinline__ void xcd_barrier(unsigned* bar_, volatile PG8_LAS unsigned* st_) {
    XcdBarrier b; b.bar = bar_; b.st = st_; b.x = 0u;
    asm volatile("s_waitcnt vmcnt(0)" ::: "memory");
    __syncthreads();
    if (threadIdx.x == 0) {
        unsigned* bar = b.bar; b.x = xb_xcc_id();
        __builtin_amdgcn_s_waitcnt(0);
        unsigned nloc = b.st[0], nx = b.st[1];
        if (nloc == 0u) { xcd_barrier_complete(bar, b.x, nloc, nx); b.st[0] = nloc; b.st[1] = nx; }
        const unsigned old = xb_add(&bar[XB_XSUB(b.x)], 1u);
        const unsigned gen = old / nloc;
        if (old + 1u == (gen + 1u) * nloc) {
            __builtin_amdgcn_fence(__ATOMIC_RELEASE, "agent");
            asm volatile("s_waitcnt vmcnt(0)" ::: "memory");
            const unsigned og = xb_add(&bar[XB_TOP], 1u);
            const unsigned tg = og / nx;
            if (og + 1u == (tg + 1u) * nx) xb_add(&bar[XB_TOPGEN], 1u);
            else XB_SPIN(xb_ld(&bar[XB_TOPGEN]) == tg, bar);
            __builtin_amdgcn_fence(__ATOMIC_ACQUIRE, "agent");
            xb_add(&bar[XB_XGEN(b.x)], 1u);
            asm volatile("s_waitcnt vmcnt(0)" ::: "memory");
        } else {
            XB_SPIN(xb_ld(&bar[XB_XGEN(b.x)]) == gen, bar);
            __builtin_amdgcn_fence(__ATOMIC_ACQUIRE, "agent");
            asm volatile("s_waitcnt vmcnt(0)" ::: "memory");
        }
    }
    __syncthreads();
}

constexpr int LDS_XB = 2 * (64 * 528 + 256 * 144);
constexpr int LDS_BYTES = LDS_XB + 64;
constexpr int NPHASE = 14;

__global__ void __launch_bounds__(512, 2) fwd_megakernel(const Params p) {
    extern __shared__ __attribute__((aligned(16))) unsigned char shm[];
    PG8_LAS unsigned char* lds = (PG8_LAS unsigned char*)shm;
    const int tid = threadIdx.x, wid = __builtin_amdgcn_readfirstlane(tid >> 6), lane = tid & 63;
    const int G = gridDim.x, gw = blockIdx.x * 8 + wid, nw = G * 8;
    unsigned char* ws = p.ws; unsigned char* sm = p.out;
    const int lo = p.ph_lo, hi = p.ph_hi;
    volatile PG8_LAS unsigned* xbst = (volatile PG8_LAS unsigned*)(lds + LDS_XB);
    if (tid < 16) xbst[tid] = 0u;
    __syncthreads();
    if (tid == 0) { const unsigned x = xb_xcc_id(); const unsigned idx = xb_add((unsigned*)(sm + SM_BAR) + XB_XCNT(x), 1u); xbst[2] = x; xbst[3] = idx; xbst[4] = blockIdx.x; xbst[5] = blockIdx.x; }
    __syncthreads();
#ifdef PROBE_TS
    unsigned long long ts[15]; ts[0] = __builtin_amdgcn_s_memrealtime();
#define STAMP(k) ts[(k) + 1] = __builtin_amdgcn_s_memrealtime()
#else
#define STAMP(k)
#endif
#define IN(k) (((PH_MASK >> (k)) & 1) && lo <= (k) && (k) < hi)
#define SEAM(k) do { if ((k) + 1 < hi) { if (lo < 0) { __threadfence(); cg::this_grid().sync(); }     \
        xcd_barrier((k) == 12 ? (unsigned*)(p.ws + WS_BAR2) : (unsigned*)(p.out + SM_BAR), (volatile PG8_LAS unsigned*)((PG8_LAS unsigned char*)shm + LDS_XB)); } STAMP(k); } while (0)
    if (IN(0)) { phase_prologue(p, gw, nw, lane); } if (lo <= 0 && 0 < hi) SEAM(0);
    if (lo <= 0 && 0 < hi) {
        if (tid == 0) { unsigned* bar = (unsigned*)(sm + SM_BAR); bool ok = (G % 8) == 0; unsigned pop = 0;
            for (unsigned j = 0; j < 16; ++j) { const unsigned c = xb_ld(&bar[XB_XCNT(j)]); if (c != 0u) { ++pop; if (c != (unsigned)G / 8u) ok = false; } }
            ok = ok && pop == 8u && xbst[2] < 8u;
            if (ok) { xbst[4] = xbst[2] * ((unsigned)G / 8u) + xbst[3];
                      xbst[5] = xbst[3] * 8u + xbst[2]; } }
        __syncthreads();
    }
    const int vcu = __builtin_amdgcn_readfirstlane((int)xbst[4]), cid = __builtin_amdgcn_readfirstlane((int)xbst[5]);
    if (IN(1)) {
        { const float* cp = (const float*)(sm + SM_CP); float* cv = (float*)(sm + SM_CV); const int gt0 = gw * 64 + lane;
          if (gt0 < 5120) { float a1 = 0.f, a2 = 0.f;
#pragma unroll
              for (int ks = 0; ks < 16; ++ks) { a1 += cp[ks * 5120 + gt0]; a2 += cp[(16 + ks) * 5120 + gt0]; }
              cv[gt0] = a1; cv[5120 + gt0] = a2; } }
        { pg8::StaticOrder S; pg8::Gemm g{(const bf16_t*)(ws + WS_XN), (const bf16_t*)(sm + SM_WIN), MTOK, 3072, 1024}; S.init(g.M, g.N, G, cid, 1);
          EpiQKV E{(bf16_t*)(ws + WS_QKV), (const float*)(sm + SM_RC), (const float*)(sm + SM_RS)}; pg8::gemm_phase(lds, g, S, E); }
#if !defined(NO_KV)
        { pg8::StaticOrder S; pg8::Gemm g{(const bf16_t*)(sm + SM_MEMB), (const bf16_t*)(sm + SM_WXKV), NMEM, 1024, 1024}; S.init(g.M, g.N, G, cid);
          EpiPlain E{(bf16_t*)(sm + SM_KM), 1024}; pg8::gemm_phase(lds, g, S, E); }
        { pg8::StaticOrder S; pg8::Gemm g{(const bf16_t*)(sm + SM_WXKV) + (size_t)1024 * 1024, (const bf16_t*)(sm + SM_MEMB), 1024, NMEM, 1024}; S.init(g.M, g.N, G, (cid + 128) % G);
          EpiPlain E{(bf16_t*)(sm + SM_VTM), NMEM}; pg8::gemm_phase(lds, g, S, E); }
#endif
    } if (lo <= 1 && 1 < hi) SEAM(1);
    if (IN(2)) { phase_attn(p, shm, wid, lane, vcu);
#ifdef DUP_ATTN
        __syncthreads(); phase_attn(p, shm, wid, lane, vcu);
#endif
    } if (lo <= 2 && 2 < hi) SEAM(2);
    if (IN(3)) { pg8::StaticOrder S; pg8::Gemm g{(const bf16_t*)(sm + OUT_O), (const bf16_t*)(sm + SM_WOUT), MTOK, 1024, 1024}; S.init(g.M, g.N, G, cid, 1);
        EpiGen<0, 1, 1, 0> E{(bf16_t*)(ws + WS_Z1), 1024, nullptr, nullptr, nullptr, (const bf16_t*)(ws + WS_XN), nullptr, nullptr, nullptr, (float*)(sm + SM_S1)}; pg8::gemm_phase(lds, g, S, E); } if (lo <= 3 && 3 < hi) SEAM(3);
    if (IN(5)) { pg8::StaticOrder S; pg8::Gemm g{(const bf16_t*)(ws + WS_Z1), (const bf16_t*)(sm + SM_WXQ), MTOK, 1024, 1024}; S.init(g.M, g.N, G, cid);
        EpiGen<1, 0, 0, 0> E{(bf16_t*)(ws + WS_QX), 1024, (const float*)(sm + SM_S1), (const float*)(sm + SM_CV), (const float*)(sm + SM_CV) + 5120, nullptr, nullptr, nullptr, nullptr, nullptr}; pg8::gemm_phase(lds, g, S, E); } if (lo <= 5 && 5 < hi) SEAM(5);
    if (IN(6)) { phase_xattn(p, shm, wid, lane); } if (lo <= 6 && 6 < hi) SEAM(6);
    if (IN(7)) { pg8::StaticOrder S; pg8::Gemm g{(const bf16_t*)(ws + WS_OC), (const bf16_t*)(sm + SM_WXO), MTOK, 1024, 1024}; S.init(g.M, g.N, G, cid);
        EpiGen<0, 2, 1, 0> E{(bf16_t*)(ws + WS_X2), 1024, nullptr, nullptr, nullptr, (const bf16_t*)(ws + WS_Z1), (const float*)(sm + SM_S1), (const float*)(sm + SM_SMALL) + SS_LN1G, (const float*)(sm + SM_SMALL) + SS_LN1B, (float*)(sm + SM_S2)};
        pg8::gemm_phase(lds, g, S, E); } if (lo <= 7 && 7 < hi) SEAM(7);
#define UPDOWN(ch) do { const size_t r0 = (size_t)(ch) * MP; \
        if (IN(9 + 2 * (ch))) { pg8::StaticOrder S; pg8::Gemm g{(const bf16_t*)(ws + WS_X2) + r0 * 1024, (const bf16_t*)(sm + SM_WUP), MP, 4096, 1024}; S.init(g.M, g.N, G, cid, 1); \
            EpiGen<1, 0, 0, 1> E{(bf16_t*)(ws + WS_H), 4096, (const float*)(sm + SM_S2) + r0 * 2, (const float*)(sm + SM_CV) + 1024, (const float*)(sm + SM_CV) + 5120 + 1024, nullptr, nullptr, nullptr, nullptr, nullptr}; pg8::gemm_phase(lds, g, S, E); } if (lo <= 9 + 2 * (ch) && 9 + 2 * (ch) < hi) SEAM(9 + 2 * (ch)); \
        if (IN(10 + 2 * (ch))) { pg8::StaticOrder S; pg8::Gemm g{(const bf16_t*)(ws + WS_H), (const bf16_t*)(sm + SM_WDOWN), MP, 1024, 4096}; S.init(g.M, g.N, G, cid); \
            EpiGen<0, 2, 0, 0> E{(bf16_t*)(ws + WS_Z3) + r0 * 1024, 1024, nullptr, nullptr, nullptr, (const bf16_t*)(ws + WS_X2) + r0 * 1024, (const float*)(sm + SM_S2) + r0 * 2, (const float*)(sm + SM_SMALL) + SS_LN2G, (const float*)(sm + SM_SMALL) + SS_LN2B, nullptr}; pg8::gemm_phase(lds, g, S, E); } if (lo <= 10 + 2 * (ch) && 10 + 2 * (ch) < hi) SEAM(10 + 2 * (ch)); } while (0)
    UPDOWN(0);
    if (lo <= 11 && 11 < hi && blockIdx.x == 0) { for (int i = tid; i < XCD_BAR_WORDS; i += 512) ((unsigned*)(ws + WS_BAR2))[i] = 0u; }
    UPDOWN(1);
#ifdef PROBE_TS
    { const float tot = (float)(ts[13] - ts[0]); const float fa = (float)(ts[PROBE_A1 + 1] - ts[PROBE_A0]) / tot, fb = (float)(ts[PROBE_B1 + 1] - ts[PROBE_B0]) / tot;
      const float fa_q = floorf(fa * 32.f + 0.5f) * (1.f / 32.f), fb_q = floorf(fb * 32.f + 0.5f) * (1.f / 32.f);
      if (IN(13)) { phase_ln<true>((const bf16_t*)(ws + WS_Z3), p.ln3_g, p.ln3_b, nullptr, (float*)p.out, gw, nw, lane, 1.f + fa_q, 1000.f * fb_q); } }
#else
    if (IN(13)) { phase_ln<true>((const bf16_t*)(ws + WS_Z3), p.ln3_g, p.ln3_b, nullptr, (float*)p.out, gw, nw, lane); }
#endif
}

extern "C" void kernel_launch(void* const* d_in, const int* in_sizes, int n_in, void* d_out, int out_size, void* d_ws, size_t ws_size, hipStream_t stream) {
    static int grid = 0;
    if (grid == 0) {
        if (n_in != 22 || ws_size < WS_NEED || (size_t)out_size != (size_t)MTOK * 1024) { fprintf(stderr, "kernel_launch: unexpected shapes (n_in %d, ws %zu, out %d); nothing launched\n", n_in, ws_size, out_size); grid = -1; return; }
        int dev = 0, cus = 0, per_cu = 0;
        hipGetDevice(&dev); hipDeviceGetAttribute(&cus, hipDeviceAttributeMultiprocessorCount, dev);
        if (hipFuncSetAttribute((const void*)fwd_megakernel, hipFuncAttributeMaxDynamicSharedMemorySize, LDS_BYTES) != hipSuccess) { fprintf(stderr, "kernel_launch: hipFuncSetAttribute failed\n"); grid = -1; return; }
        if (hipOccupancyMaxActiveBlocksPerMultiprocessor(&per_cu, (const void*)fwd_megakernel, 512, LDS_BYTES) != hipSuccess || per_cu < 1) { fprintf(stderr, "kernel_launch: occupancy query says %d\n", per_cu); per_cu = 1; }
        (void)hipGetLastError();
        grid = cus * 1;
    }
    if (grid < 0) return;
    Params p{};
    const float** pp = (const float**)&p;
    for (int i = 0; i < 22; ++i) pp[i] = (const float*)d_in[i];
    p.out = (unsigned char*)d_out; p.ws = (unsigned char*)d_ws;
    if (hipMemsetAsync((unsigned char*)d_out + SM_BAR, 0, 65536 + 2 * MiB, stream) != hipSuccess) { fprintf(stderr, "kernel_launch: hipMemsetAsync of the barrier words failed\n"); return; }
#if N_LAUNCHES == 1
    p.ph_lo = 0; p.ph_hi = NPHASE;
    void* args[] = {(void*)&p};
    hipError_t e = hipLaunchCooperativeKernel((const void*)fwd_megakernel, dim3(grid), dim3(512), args, LDS_BYTES, stream);
    if (e != hipSuccess) fprintf(stderr, "cooperative launch failed: %s (grid %d)\n", hipGetErrorString(e), grid);
#else
    for (int ph = 0; ph < NPHASE; ++ph) { p.ph_lo = ph; p.ph_hi = ph + 1; hipLaunchKernelGGL(fwd_megakernel, dim3(grid), dim3(512), LDS_BYTES, stream, p); }
#endif
}
```
